# Optimizing an MI355X kernel written in HIP

```python
import jax, jax.numpy as jnp
from jax import lax
import numpy as np

D_MODEL = 1024
BATCH = 2
SEQ = 8192
DEPTH = 1

GRID_W = 64
CTX_LEN = 256
D_MIX = D_MODEL
D_FOURIER = D_MIX // 2
D_LRU = D_MIX - D_FOURIER
N_FOURIER_GROUPS = 4
FOURIER_GROUP_DIM = D_FOURIER // N_FOURIER_GROUPS
N_LRU_HEADS = 4
LRU_HEAD_DIM = D_LRU // N_LRU_HEADS
CONV_WIDTH = 4
CONV_PAD = (2, 1)
LRU_C = 8.0
EPS = 1e-6

kernel_name = "hybrid_fourier_rglru_prefix_dit_layer"


def rmsnorm(x, g):
    xf = x.astype(jnp.float32)
    y = xf * lax.rsqrt(jnp.mean(xf * xf, axis=-1, keepdims=True) + EPS)
    return (y * g.astype(jnp.float32)).astype(x.dtype)


def modulate(x, g, shift, scale):
    return rmsnorm(x, g) * (1.0 + scale) + shift


def in_proj(h, w_in):
    z = h @ w_in
    return jnp.split(z, [D_FOURIER, 2 * D_FOURIER, 2 * D_FOURIER + D_LRU], axis=-1)


def fourier_branch(u, w_four):
    b_, l_, _ = u.shape
    ug = u.astype(jnp.float32).reshape(b_, l_, N_FOURIER_GROUPS, FOURIER_GROUP_DIM)
    mixed = jnp.fft.fftn(ug, axes=(1, 3), norm="ortho").real
    return mixed.reshape(b_, l_, D_FOURIER).astype(u.dtype) @ w_four


def dwconv_centred(u, w, b):
    y = lax.conv_general_dilated(u, w[:, None, :].astype(u.dtype), window_strides=(1,),
                                 padding=[CONV_PAD],
                                 dimension_numbers=("NWC", "WIO", "NWC"),
                                 feature_group_count=D_LRU)
    return y + b


def block_diag(u, w, b):
    b_, l_, _ = u.shape
    uh = u.reshape(b_, l_, N_LRU_HEADS, LRU_HEAD_DIM)
    return jnp.einsum("blhd,hde->blhe", uh, w).reshape(b_, l_, D_LRU) + b


def _combine(left, right):
    a1, b1 = left
    a2, b2 = right
    return a1 * a2, a2 * b1 + b2


def rglru_direction(u, w_rg, b_rg, w_ig, b_ig, lam, h0, reverse):
    r = jax.nn.sigmoid(block_diag(u, w_rg, b_rg).astype(jnp.float32))
    i = jax.nn.sigmoid(block_diag(u, w_ig, b_ig).astype(jnp.float32))
    log_a = -LRU_C * r * jax.nn.softplus(-lam.astype(jnp.float32))
    a = jnp.exp(log_a)
    bx = jnp.sqrt(-jnp.expm1(2.0 * log_a)) * (i * u.astype(jnp.float32))
    a_cum, b_cum = lax.associative_scan(_combine, (a, bx), axis=1, reverse=reverse)
    h = a_cum * h0[:, None, :] + b_cum
    final = h[:, 0] if reverse else h[:, -1]
    return h, final


def lru_branch(u, conv_w, conv_b, w_rg, b_rg, w_ig, b_ig, lam, h0_fwd, h0_bwd):
    v = dwconv_centred(u, conv_w, conv_b)
    h_f, fin_f = rglru_direction(v, w_rg[0], b_rg[0], w_ig[0], b_ig[0], lam[0], h0_fwd, False)
    h_b, fin_b = rglru_direction(v, w_rg[1], b_rg[1], w_ig[1], b_ig[1], lam[1], h0_bwd, True)
    return (h_f + h_b).astype(u.dtype), fin_f, fin_b


def out_proj(y_f, g_f, y_l, g_l, w_out):
    y = jnp.concatenate([y_f * jax.nn.silu(g_f), y_l * jax.nn.silu(g_l)], axis=-1)
    return y @ w_out


def setup_inputs(seed: int = 0) -> dict:
    key = jax.random.key(seed)
    ks = jax.random.split(key, 20)
    f32 = jnp.float32
    x = jax.random.normal(ks[0], (BATCH, SEQ, D_MODEL), f32)
    c = jax.random.normal(ks[1], (BATCH, D_MODEL), f32)
    ctx = jax.random.normal(ks[2], (BATCH, CTX_LEN, D_MODEL), f32)
    c_ctx = jax.random.normal(ks[3], (D_MODEL,), f32)
    w_ada = jax.random.normal(ks[4], (DEPTH, D_MODEL, 3 * D_MODEL), f32) * (0.5 * D_MODEL ** -0.5)
    b_ada = jax.random.normal(ks[5], (DEPTH, 3 * D_MODEL), f32) * 0.02
    norm_gain = 1.0 + 0.05 * jax.random.normal(ks[6], (DEPTH, D_MODEL), f32)
    w_in = jax.random.normal(ks[7], (DEPTH, D_MODEL, 2 * D_MIX), f32) * D_MODEL ** -0.5
    w_four = jax.random.normal(ks[8], (DEPTH, D_FOURIER, D_FOURIER), f32) * D_FOURIER ** -0.5
    conv_w = jax.random.normal(ks[9], (DEPTH, CONV_WIDTH, D_LRU), f32) * CONV_WIDTH ** -0.5
    conv_b = jax.random.normal(ks[10], (DEPTH, D_LRU), f32) * 0.02
    gshape = (DEPTH, 2, N_LRU_HEADS, LRU_HEAD_DIM, LRU_HEAD_DIM)
    w_rg = jax.random.normal(ks[11], gshape, f32) * LRU_HEAD_DIM ** -0.5
    b_rg = jax.random.normal(ks[12], (DEPTH, 2, D_LRU), f32) * 0.02
    w_ig = jax.random.normal(ks[13], gshape, f32) * LRU_HEAD_DIM ** -0.5
    b_ig = jax.random.normal(ks[14], (DEPTH, 2, D_LRU), f32) * 0.02
    u = jax.random.uniform(ks[15], (DEPTH, 2, D_LRU), f32, minval=0.9, maxval=0.999)
    p = u ** (1.0 / LRU_C)
    lam = jnp.log(p) - jnp.log1p(-p)
    w_out = jax.random.normal(ks[16], (DEPTH, D_MIX, D_MODEL), f32) * D_MIX ** -0.5
    final_gain = 1.0 + 0.05 * jax.random.normal(ks[17], (D_MODEL,), f32)
    return {"x": x, "c": c, "ctx": ctx, "c_ctx": c_ctx, "w_ada": w_ada, "b_ada": b_ada,
            "norm_gain": norm_gain, "w_in": w_in, "w_four": w_four, "conv_w": conv_w,
            "conv_b": conv_b, "w_rg": w_rg, "b_rg": b_rg, "w_ig": w_ig, "b_ig": b_ig,
            "lam": lam, "w_out": w_out, "final_gain": final_gain}


def reference(x, c, ctx, c_ctx, w_ada, b_ada, norm_gain, w_in, w_four, conv_w, conv_b,
              w_rg, b_rg, w_ig, b_ig, lam, w_out, final_gain):
    bsz = x.shape[0]
    for l in range(DEPTH):
        mod = jax.nn.silu(c) @ w_ada[l] + b_ada[l]
        shift, scale, gate = jnp.split(mod[:, None, :], 3, axis=-1)
        mod_c = jax.nn.silu(c_ctx) @ w_ada[l] + b_ada[l]
        shift_c, scale_c, gate_c = jnp.split(mod_c, 3)

        hx = modulate(x, norm_gain[l], shift, scale)
        hc = modulate(ctx, norm_gain[l], shift_c, scale_c)
        uf_x, gf_x, ul_x, gl_x = in_proj(hx, w_in[l])
        uf_c, gf_c, ul_c, gl_c = in_proj(hc, w_in[l])

        zeros = jnp.zeros((bsz, D_LRU), jnp.float32)
        yl_c, fin_f, fin_b = lru_branch(ul_c, conv_w[l], conv_b[l], w_rg[l], b_rg[l],
                                        w_ig[l], b_ig[l], lam[l], zeros, zeros)
        yl_x, _, _ = lru_branch(ul_x, conv_w[l], conv_b[l], w_rg[l], b_rg[l],
                                w_ig[l], b_ig[l], lam[l], fin_f, fin_b)
        yf_x = fourier_branch(uf_x, w_four[l])
        x = x + gate * out_proj(yf_x, gf_x, yl_x, gl_x, w_out[l])
        if l < DEPTH - 1:
            yf_c = fourier_branch(uf_c, w_four[l])
            ctx = ctx + gate_c * out_proj(yf_c, gf_c, yl_c, gl_c, w_out[l])
    return rmsnorm(x, final_gain)
```

```cpp
#include <hip/hip_runtime.h>
#include <stdint.h>

typedef unsigned short bf16_t;

#define NB 2
#define TT 8192
#define DM 1024
#define CTXL 256
#define MLAT (NB * TT)
#define MCTX (NB * CTXL)
#define MTOT (MLAT + MCTX)
#define DF 512
#define DL 512
#define HD 128

__device__ __forceinline__ float bf2f(bf16_t b) { return __uint_as_float(((unsigned)b) << 16); }
__device__ __forceinline__ bf16_t f2bf(float f) { unsigned u = __float_as_uint(f); u += 0x7fffu + ((u >> 16) & 1u); return (bf16_t)(u >> 16); }
__device__ __forceinline__ float siluf(float v) { return v / (1.0f + expf(-v)); }
__device__ __forceinline__ float sigmf(float v) { return 1.0f / (1.0f + expf(-v)); }

constexpr size_t MiB = 1u << 20;
constexpr size_t WS_CTL = 0, CTL_ZERO_BYTES = 256 * 1024;
constexpr size_t WS_MODP = 512 * 1024;
constexpr size_t WS_MOD = 1 * MiB;
constexpr size_t WS_SUM = 1 * MiB + 64 * 1024;
constexpr size_t WS_WREST = 3 * MiB;
constexpr size_t WS_WFOLD = 6 * MiB;
constexpr size_t WS_WOUT = 8 * MiB;
constexpr size_t WS_WG = 10 * MiB;
constexpr size_t WS_MT = 11 * MiB;
constexpr size_t WS_WINF = 13 * MiB;
constexpr size_t WS_HX = 16 * MiB;
constexpr size_t WS_ZT = 50 * MiB;
constexpr size_t WS_GF = 82 * MiB;
constexpr size_t WS_UL = 98 * MiB;
constexpr size_t WS_GL = 115 * MiB;
constexpr size_t WS_YFT = 131 * MiB;
constexpr size_t WS_Y = 147 * MiB;
constexpr size_t WS_HF = 179 * MiB;
constexpr size_t WS_HB = 211 * MiB;

#define LAS __attribute__((address_space(3)))
typedef short bf16x8 __attribute__((ext_vector_type(8)));
typedef float f32x4 __attribute__((ext_vector_type(4)));
typedef float f32x2 __attribute__((ext_vector_type(2)));
typedef float f32x16 __attribute__((ext_vector_type(16)));
typedef unsigned u32x4 __attribute__((ext_vector_type(4)));
typedef unsigned u32x2 __attribute__((ext_vector_type(2)));
typedef __bf16 bf16x2_t __attribute__((ext_vector_type(2)));
#define LDS_WAIT() asm volatile("s_waitcnt lgkmcnt(0)" ::: "memory")
#define VM_WAIT() asm volatile("s_waitcnt vmcnt(0)" ::: "memory")

__device__ __forceinline__ unsigned pk2(float a, float b) { f32x2 v = {a, b}; bf16x2_t r = __builtin_convertvector(v, bf16x2_t); return __builtin_bit_cast(unsigned, r); }
__device__ __forceinline__ float fsilu(float v) { return v * __builtin_amdgcn_rcpf(1.0f + __expf(-v)); }
__device__ __forceinline__ float fsigm(float v) { return __builtin_amdgcn_rcpf(1.0f + __expf(-v)); }

constexpr int NWAVES = 8;
constexpr int RING_BYTES = 131072;
constexpr int MISC_OFF = 146432;
constexpr int MISC_CS128_OFF = 145408;
constexpr int LDS_BYTES = 147456;

#define XB_TMO      128
#define XB_XCNT(j)  (256  + 64 * (j))
#define XB_XSUB(j)  (1280 + 64 * (j))
#define XB_XGEN(j)  (2304 + 64 * (j))
#define XB_TOP      3328
#define XB_TOPGEN   3392
#define XCD_BAR_WORDS 3456
#define XB_SPIN_CAP (1u << 18)
__device__ __forceinline__ unsigned xb_ld(unsigned* p)              { return __hip_atomic_load(p, __ATOMIC_RELAXED, __HIP_MEMORY_SCOPE_AGENT); }
__device__ __forceinline__ unsigned xb_add(unsigned* p, unsigned v) { return __hip_atomic_fetch_add(p, v, __ATOMIC_RELAXED, __HIP_MEMORY_SCOPE_AGENT); }
__device__ __forceinline__ unsigned xb_xcc_id() { return (unsigned)__builtin_amdgcn_s_getreg((3 << 11) | 20) & 0xFu; }
#define XB_SPIN(cond, bar) do { unsigned _sp = 0; while (cond) { __builtin_amdgcn_s_sleep(1); \
    if ((++_sp & 255u) == 0u) { if (xb_ld(&(bar)[XB_TMO])) break; if (_sp > XB_SPIN_CAP) { atomicAdd(&(bar)[XB_TMO], 1u); break; } } } } while (0)
struct XcdBarrier { unsigned* bar; unsigned x; volatile LAS unsigned* st; };
__device__ __forceinline__ XcdBarrier xcd_barrier_post(unsigned* bar, volatile LAS unsigned* st) {
    XcdBarrier b; b.bar = bar; b.x = xb_xcc_id(); b.st = st;
    if (threadIdx.x == 0) (void)xb_add(&bar[XB_XCNT(b.x)], 1u);
    return b;
}
__device__ __forceinline__ void xcd_barrier_complete(unsigned* bar, unsigned x, unsigned& nloc, unsigned& nx) {
    const unsigned G = gridDim.x * gridDim.y * gridDim.z;
    unsigned sum, cnt, mine, sp = 0u;
    for (;;) {
        sum = 0u; cnt = 0u; mine = 0u;
#pragma unroll
        for (unsigned j = 0; j < 16; ++j) { const unsigned c = xb_ld(&bar[XB_XCNT(j)]); sum += c; cnt += (c > 0u) ? 1u : 0u; mine = (j == x) ? c : mine; }
        if (sum == G) break;
        __builtin_amdgcn_s_sleep(1);
        if ((++sp & 255u) == 0u) { if (xb_ld(&bar[XB_TMO])) break; if (sp > XB_SPIN_CAP) { atomicAdd(&bar[XB_TMO], 1u); break; } }
    }
    nloc = mine > 0u ? mine : 1u; nx = cnt > 0u ? cnt : 1u;
}
__device__ __forceinline__ void xcd_barrier(const XcdBarrier& b) {
    asm volatile("s_waitcnt vmcnt(0)" ::: "memory");
    __syncthreads();
    if (threadIdx.x == 0) {
        unsigned* bar = b.bar;
        __builtin_amdgcn_s_waitcnt(0);
        unsigned nloc = b.st[0], nx = b.st[1];
        if (nloc == 0u) { xcd_barrier_complete(bar, b.x, nloc, nx); b.st[0] = nloc; b.st[1] = nx; }
        const unsigned old = xb_add(&bar[XB_XSUB(b.x)], 1u);
        const unsigned gen = old / nloc;
        if (old + 1u == (gen + 1u) * nloc) {
            __builtin_amdgcn_fence(__ATOMIC_RELEASE, "agent");
            asm volatile("s_waitcnt vmcnt(0)" ::: "memory");
            const unsigned og = xb_add(&bar[XB_TOP], 1u);
            const unsigned tg = og / nx;
            if (og + 1u == (tg + 1u) * nx) xb_add(&bar[XB_TOPGEN], 1u);
            else XB_SPIN(xb_ld(&bar[XB_TOPGEN]) == tg, bar);
            __builtin_amdgcn_fence(__ATOMIC_ACQUIRE, "agent");
            xb_add(&bar[XB_XGEN(b.x)], 1u);
            asm volatile("s_waitcnt vmcnt(0)" ::: "memory");
        } else {
            XB_SPIN(xb_ld(&bar[XB_XGEN(b.x)]) == gen, bar);
            __builtin_amdgcn_fence(__ATOMIC_ACQUIRE, "agent");
            asm volatile("s_waitcnt vmcnt(0)" ::: "memory");
        }
    }
    __syncthreads();
}

namespace pg8 {
constexpr int BM = 256, BK = 64, HALF = 128, HTB = HALF * BK * 2, STAGE_BYTES = 8 * HTB;
__device__ __forceinline__ int lds_byte(int r, int c) { const int st = (r >> 4) * 2 + (c >> 5), rr = r & 15, cc = c & 31, ob = rr * 64 + cc * 2; return st * 1024 + (ob ^ (((ob >> 9) & 1) << 5)); }
__device__ __forceinline__ void stage_rc(int b, int& R, int& C) { const int st = b / 1024, sb = b % 1024, swz = sb ^ (((sb >> 9) & 1) << 5); R = (st >> 1) * 16 + swz / 64; C = (st & 1) * 32 + (swz % 64) / 2; }
__device__ __forceinline__ int perm32(int rho) { const int n = rho >> 4, i = rho & 15; return 8 * (i >> 2) + 4 * n + (i & 3); }

struct Unit { const char* a; const char* b; char* o; int ldc; int flags; int pm; int pn; };

enum { PAT_NAT = 0, PAT_PERM = 1, PAT_FFT = 2 };
template <int PAT> __device__ __forceinline__ int brow(int R) {
    if (PAT == PAT_NAT) return R;
    const int Rb = (R & ~31) + perm32(R & 31);
    if (PAT == PAT_PERM) return Rb;
    return (Rb >> 6) + 128 * (Rb & 63);
}
template <int PAT> __device__ __forceinline__ size_t bhstep(int K) { return PAT == PAT_FFT ? (size_t)2 * K * 2 : (size_t)HALF * K * 2; }

template <int PAT0, int PAT1, class Sched, class Epi>
__device__ __forceinline__ void gemm_phase(LAS unsigned char* lds, const int K, const Sched& S, const Epi& E) {
    const int tid = threadIdx.x, wid = __builtin_amdgcn_readfirstlane(tid >> 6), lane = tid & 63, wr = wid >> 2, wc = wid & 3, fr = lane & 15, fq = lane >> 4;
    const int nt = K / BK;
    unsigned voffA[2], voffB0[2], voffB1[2];
#pragma unroll
    for (int i = 0; i < 2; ++i) { int R, C; stage_rc(tid * 16 + i * 8192, R, C);
        voffA[i] = (unsigned)(R * K + C) * 2u; voffB0[i] = (unsigned)(brow<PAT0>(R) * K + C) * 2u; voffB1[i] = (unsigned)(brow<PAT1>(R) * K + C) * 2u; }
    const size_t kstep = (size_t)(BK * 2);
    const size_t hstepA = (size_t)HALF * K * 2;
    const size_t hsB0 = bhstep<PAT0>(K), hsB1 = bhstep<PAT1>(K);
    const unsigned ldsw = (unsigned)wid * 1024u;
    const int aoff = lds_byte(wr * 64 + fr, fq * 8), boff = lds_byte(wc * 32 + fr, fq * 8);
#define PG8_SA(b, h) (((b) * 2 + (h)) * HTB)
#define PG8_SB(b, h) ((4 + (b) * 2 + (h)) * HTB)
#define PG8_STAGE(bufoff, gbase, v0, v1) do { \
        __builtin_amdgcn_global_load_lds((const unsigned*)((const char*)(gbase) + (v0)), (LAS unsigned*)(lds + (bufoff) + ldsw), 16, 0, 0); \
        __builtin_amdgcn_global_load_lds((const unsigned*)((const char*)(gbase) + (v1)), (LAS unsigned*)(lds + (bufoff) + ldsw + 8192), 16, 0, 0); } while (0)
#define PG8_LDA(dst, b, h) do { _Pragma("unroll") for (int m = 0; m < 4; ++m) _Pragma("unroll") for (int k = 0; k < 2; ++k) dst[m][k] = *(const LAS bf16x8*)(lds + PG8_SA(b, h) + aoff + m * 2048 + k * 1024); } while (0)
#define PG8_LDB(dst, b, h) do { _Pragma("unroll") for (int n = 0; n < 2; ++n) _Pragma("unroll") for (int k = 0; k < 2; ++k) dst[n][k] = *(const LAS bf16x8*)(lds + PG8_SB(b, h) + boff + n * 2048 + k * 1024); } while (0)
#define PG8_MMA(ai, bj, At, Bt) do { __builtin_amdgcn_s_setprio(1); _Pragma("unroll") for (int m = 0; m < 4; ++m) _Pragma("unroll") for (int n = 0; n < 2; ++n) _Pragma("unroll") for (int k = 0; k < 2; ++k) \
        acc[ai][bj][m][n] = __builtin_amdgcn_mfma_f32_16x16x32_bf16(Bt[n][k], At[m][k], acc[ai][bj][m][n], 0, 0, 0); __builtin_amdgcn_s_setprio(0); } while (0)
#define PG8_WAIT_V(n) asm volatile("s_waitcnt vmcnt(" #n ")" ::: "memory")
#define PG8_WAIT_L(n) asm volatile("s_waitcnt lgkmcnt(" #n ")" ::: "memory")
#define PG8_BAR __builtin_amdgcn_s_barrier()
#define PG8_SCHED __builtin_amdgcn_sched_barrier(0)
    Unit cur, nxt; int ui = 0;
    if (!S.next(0, cur)) return;
    f32x4 acc[2][2][4][2];
#pragma unroll
    for (int a = 0; a < 2; ++a)
#pragma unroll
        for (int b = 0; b < 2; ++b)
#pragma unroll
            for (int m = 0; m < 4; ++m)
#pragma unroll
                for (int n = 0; n < 2; ++n) acc[a][b][m][n] = (f32x4){0.f, 0.f, 0.f, 0.f};
    bf16x8 At[4][2], B0[2][2], B1[2][2];
    const char* cA = cur.a; const char* cB = cur.b;
    unsigned cv0 = (cur.flags & 1) ? voffB1[0] : voffB0[0], cv1 = (cur.flags & 1) ? voffB1[1] : voffB0[1];
    size_t chb = (cur.flags & 1) ? hsB1 : hsB0;
    PG8_STAGE(PG8_SB(0, 0), cB, cv0, cv1); PG8_STAGE(PG8_SA(0, 0), cA, voffA[0], voffA[1]); PG8_STAGE(PG8_SB(0, 1), cB + chb, cv0, cv1); PG8_STAGE(PG8_SA(0, 1), cA + hstepA, voffA[0], voffA[1]);
    if (wr == 1) PG8_BAR;
    PG8_WAIT_V(4); PG8_BAR;
    PG8_STAGE(PG8_SB(1, 0), cB + kstep, cv0, cv1); PG8_STAGE(PG8_SA(1, 0), cA + kstep, voffA[0], voffA[1]); PG8_STAGE(PG8_SB(1, 1), cB + chb + kstep, cv0, cv1);
    PG8_WAIT_V(6); PG8_BAR;
    for (;;) {
        const bool has_next = S.next(ui + 1, nxt);
        const char* nA = has_next ? nxt.a : cA; const char* nB = has_next ? nxt.b : cB;
        const unsigned nv0 = has_next ? ((nxt.flags & 1) ? voffB1[0] : voffB0[0]) : cv0, nv1 = has_next ? ((nxt.flags & 1) ? voffB1[1] : voffB0[1]) : cv1;
        const size_t nhb = has_next ? ((nxt.flags & 1) ? hsB1 : hsB0) : chb;
        for (int t = 0; t < nt; t += 2) {
            const bool last = (t == nt - 2);
            const char* a1 = cA + (size_t)(t + 1) * kstep;
            const char* a2 = last ? nA : cA + (size_t)(t + 2) * kstep; const char* b2 = last ? nB : cB + (size_t)(t + 2) * kstep;
            const unsigned w0 = last ? nv0 : cv0, w1 = last ? nv1 : cv1; const size_t hb2 = last ? nhb : chb;
            const char* a3 = a2 + kstep; const char* b3 = b2 + kstep;
            PG8_LDB(B0, 0, 0); PG8_SCHED; PG8_LDA(At, 0, 0); PG8_STAGE(PG8_SA(1, 1), a1 + hstepA, voffA[0], voffA[1]);
            PG8_WAIT_L(8); PG8_BAR; PG8_WAIT_L(0); PG8_MMA(0, 0, At, B0); PG8_BAR; PG8_SCHED;
            PG8_LDB(B1, 0, 1); PG8_STAGE(PG8_SB(0, 0), b2, w0, w1);
            PG8_BAR; PG8_WAIT_L(0); PG8_MMA(0, 1, At, B1); PG8_BAR;
            PG8_LDA(At, 0, 1); PG8_STAGE(PG8_SA(0, 0), a2, voffA[0], voffA[1]);
            PG8_BAR; PG8_WAIT_L(0); PG8_MMA(1, 0, At, B0); PG8_BAR; PG8_SCHED;
            PG8_STAGE(PG8_SB(0, 1), b2 + hb2, w0, w1);
            PG8_WAIT_V(6); PG8_BAR; PG8_MMA(1, 1, At, B1); PG8_BAR;
            PG8_LDB(B0, 1, 0); PG8_SCHED; PG8_LDA(At, 1, 0); PG8_STAGE(PG8_SA(0, 1), a2 + hstepA, voffA[0], voffA[1]);
            PG8_WAIT_L(8); PG8_BAR; PG8_WAIT_L(0); PG8_MMA(0, 0, At, B0); PG8_BAR; PG8_SCHED;
            PG8_LDB(B1, 1, 1); PG8_STAGE(PG8_SB(1, 0), b3, w0, w1);
            PG8_BAR; PG8_WAIT_L(0); PG8_MMA(0, 1, At, B1); PG8_BAR;
            PG8_LDA(At, 1, 1); PG8_STAGE(PG8_SA(1, 0), a3, voffA[0], voffA[1]);
            PG8_BAR; PG8_WAIT_L(0); PG8_MMA(1, 0, At, B0); PG8_BAR; PG8_SCHED;
            PG8_STAGE(PG8_SB(1, 1), b3 + hb2, w0, w1);
            PG8_WAIT_V(6); PG8_BAR; PG8_MMA(1, 1, At, B1); PG8_BAR;
        }
        E(acc, cur, wr, wc, fr, fq);
        if (!has_next) break;
#pragma unroll
        for (int a = 0; a < 2; ++a)
#pragma unroll
            for (int b = 0; b < 2; ++b)
#pragma unroll
                for (int m = 0; m < 4; ++m)
#pragma unroll
                    for (int n = 0; n < 2; ++n) acc[a][b][m][n] = (f32x4){0.f, 0.f, 0.f, 0.f};
        cur = nxt; cA = nA; cB = nB; cv0 = nv0; cv1 = nv1; chb = nhb; ++ui;
    }
    PG8_WAIT_V(0);
    if (wr == 0) PG8_BAR;
    PG8_BAR;
#undef PG8_SA
#undef PG8_SB
#undef PG8_STAGE
#undef PG8_LDA
#undef PG8_LDB
#undef PG8_MMA
#undef PG8_WAIT_V
#undef PG8_WAIT_L
#undef PG8_BAR
#undef PG8_SCHED
}

struct EpiBf16 {
    __device__ __forceinline__ void operator()(const f32x4 (&acc)[2][2][4][2], const Unit& u, int wr, int wc, int fr, int fq) const {
        bf16_t* base = (bf16_t*)u.o + (size_t)(wr * 64 + fr) * u.ldc + wc * 32 + 8 * fq;
        const bool act = (u.flags & 16) != 0;
#pragma unroll
        for (int ai = 0; ai < 2; ++ai)
#pragma unroll
            for (int m = 0; m < 4; ++m) { bf16_t* rowp = base + (size_t)(ai * HALF + m * 16) * u.ldc;
#pragma unroll
                for (int bj = 0; bj < 2; ++bj) { f32x4 v0 = acc[ai][bj][m][0], v1 = acc[ai][bj][m][1];
                    if (act) {
#pragma unroll
                        for (int j = 0; j < 4; ++j) { v0[j] = fsilu(v0[j]); v1[j] = fsilu(v1[j]); } }
                    u32x4 w; w.x = pk2(v0[0], v0[1]); w.y = pk2(v0[2], v0[3]); w.z = pk2(v1[0], v1[1]); w.w = pk2(v1[2], v1[3]);
                    *(u32x4*)(rowp + bj * HALF) = w; } }
    }
};
struct EpiOutF32 {
    const float* x; float* out; const float* mod;
    __device__ __forceinline__ void operator()(const f32x4 (&acc)[2][2][4][2], const Unit& u, int wr, int wc, int fr, int fq) const {
        const int row0 = u.pm * BM + wr * 64 + fr, col0 = u.pn * BM + wc * 32 + 4 * fq;
        const int b = (u.pm * BM) / TT;
        f32x4 gv[2][2];
#pragma unroll
        for (int bj = 0; bj < 2; ++bj)
#pragma unroll
            for (int n = 0; n < 2; ++n) gv[bj][n] = *(const f32x4*)(mod + b * 3072 + 2048 + col0 + bj * HALF + n * 16);
#pragma unroll
        for (int ai = 0; ai < 2; ++ai)
#pragma unroll
            for (int m = 0; m < 4; ++m) { const size_t off = (size_t)(row0 + ai * HALF + m * 16) * DM + col0;
#pragma unroll
                for (int bj = 0; bj < 2; ++bj)
#pragma unroll
                    for (int n = 0; n < 2; ++n) { const f32x4 xv = *(const f32x4*)(x + off + bj * HALF + n * 16);
                        *(f32x4*)(out + off + bj * HALF + n * 16) = xv + gv[bj][n] * acc[ai][bj][m][n]; } }
    }
};
}

struct Args { const float* in[18]; float* out; unsigned char* ws; int ph_lo, ph_hi; };
struct Frame {
    LAS unsigned char* lds; volatile LAS unsigned* MISC; unsigned* ctl;
    int tid, lane, wave, G, bid, vcu;
    unsigned char* ws;
};
#define WSP(T, off) ((T*)(F.ws + (off)))

__device__ __forceinline__ void transpose_item(const float* W, int ldw, bf16_t* WT, int ldt, LAS float* scr, int kb, int nb, int lane) {
    const int k0 = 64 * kb, n0 = 32 * nb;
#pragma unroll 8
    for (int i = 0; i < 32; ++i) { const int kk = 2 * i + (lane >> 5); scr[kk * 33 + (lane & 31)] = W[(size_t)(k0 + kk) * ldw + n0 + (lane & 31)]; }
    LDS_WAIT(); asm volatile("" ::: "memory");
    const int c = lane & 7;
#pragma unroll
    for (int j = 0; j < 4; ++j) { const int n = (lane >> 3) + 8 * j; const LAS float* s = scr + (8 * c) * 33 + n;
        u32x4 o; o.x = pk2(s[0 * 33], s[1 * 33]); o.y = pk2(s[2 * 33], s[3 * 33]); o.z = pk2(s[4 * 33], s[5 * 33]); o.w = pk2(s[6 * 33], s[7 * 33]);
        *(u32x4*)(WT + (size_t)(n0 + n) * ldt + k0 + 8 * c) = o; }
    LDS_WAIT(); asm volatile("" ::: "memory");
}
struct SchedP1 {
    int G, c; unsigned char* ws;
    __device__ __forceinline__ bool next(int i, pg8::Unit& u) const {
        const int L = i * G + c;
        if (L < 256) {
            const int x = L & 7, j = L >> 3, pm = j & 3, pn = x * 8 + (j >> 2), b = pn >> 5, pnl = pn & 31;
            u.a = (const char*)(ws + WS_WFOLD) + (size_t)pm * 256 * DM * 2;
            u.b = (const char*)(ws + WS_HX) + ((size_t)b * TT + 4 * pnl) * DM * 2;
            u.o = (char*)(ws + WS_ZT) + ((size_t)pm * 256 * MLAT + (size_t)pn * 256) * 2;
            u.ldc = MLAT; u.flags = 1; u.pm = pm; u.pn = pn; return true;
        }
        const int Lr = L - 256; int pm, pn;
        if (Lr < 384) { const int x = Lr & 7, j = Lr >> 3; pm = 8 * x + (j & 7); pn = j >> 3; }
        else if (Lr < 388) { const int q = Lr - 384; pm = 64 + (q >> 1); pn = 2 + (q & 1); }
        else return false;
        const int seg = pn >> 1;
        u.a = (const char*)(ws + WS_HX) + (size_t)pm * 256 * DM * 2;
        u.b = (const char*)(ws + WS_WREST) + (size_t)pn * 256 * DM * 2;
        unsigned char* ob = ws + (seg == 0 ? WS_GF : (seg == 1 ? WS_UL : WS_GL));
        u.o = (char*)ob + ((size_t)pm * 256 * 512 + (size_t)(pn & 1) * 256) * 2;
        u.ldc = 512; u.flags = (seg != 1) ? 16 : 0; u.pm = pm; u.pn = pn; return true;
    }
};
struct SchedP4 {
    int G, c; unsigned char* ws;
    __device__ __forceinline__ bool next(int i, pg8::Unit& u) const {
        const int L = i * G + c; if (L >= 256) return false;
        const int x = L & 7, j = L >> 3, pm = 8 * x + (j & 7), pn = j >> 3;
        u.a = (const char*)(ws + WS_Y) + (size_t)pm * 256 * DM * 2;
        u.b = (const char*)(ws + WS_WOUT) + (size_t)pn * 256 * DM * 2;
        u.o = nullptr; u.ldc = DM; u.flags = 0; u.pm = pm; u.pn = pn; return true;
    }
};

__device__ __forceinline__ float wave_sum(float v) {
#pragma unroll
    for (int o = 1; o < 64; o <<= 1) v += __shfl_xor(v, o);
    return v;
}
struct SchedFold {
    int G, c; unsigned char* ws;
    __device__ __forceinline__ bool next(int i, pg8::Unit& u) const {
        const int L = i * G + c; if (L >= 16) return false;
        const int pm = L >> 2, pn = L & 3;
        u.a = (const char*)(ws + WS_MT) + (size_t)pm * 256 * 512 * 2;
        u.b = (const char*)(ws + WS_WINF) + (size_t)pn * 256 * 512 * 2;
        u.o = (char*)(ws + WS_WFOLD) + ((size_t)pm * 256 * DM + (size_t)pn * 256) * 2;
        u.ldc = DM; u.flags = 0; u.pm = pm; u.pn = pn; return true;
    }
};

__device__ __forceinline__ void p0_prep(Frame& F, const Args& args) {
    LAS float* scr = (LAS float*)(F.lds + F.wave * 16384);
    LAS f32x2* cs128 = (LAS f32x2*)(F.lds + MISC_CS128_OFF);
    const int gw = F.vcu * NWAVES + F.wave, NGW = F.G * NWAVES, lane = F.lane;
    const float* w_in = args.in[7]; const float* w_out = args.in[16]; const float* w_rg = args.in[11]; const float* w_ig = args.in[13];
    const float* w4 = args.in[8]; const float* w_ada = args.in[4];
    constexpr int I_MT = 512, I_MOD = 384, I_REST = 16 * 48, I_OUT = 16 * 32, I_G = 16 * 8, I_WINF = 1024;
    for (int it = gw; it < I_MT + I_MOD + I_REST + I_OUT + I_G + I_WINF; it += NGW) {
        int r = it;
        if (r < I_MT) {
            const int g = r >> 7, ob = (r >> 4) & 7, cb = r & 15, o = 64 * ob + lane, c0 = 8 * cb;
            float aC[8], aS[8];
#pragma unroll
            for (int cc = 0; cc < 8; ++cc) { aC[cc] = 0.f; aS[cc] = 0.f; }
            const float* wp = w4 + (size_t)(g * 128) * 512 + o;
#pragma unroll 4
            for (int m = 0; m < 128; ++m) {
                const float wv = wp[(size_t)m * 512];
#pragma unroll
                for (int cc = 0; cc < 8; ++cc) { const f32x2 t = cs128[(m * (c0 + cc)) & 127]; aC[cc] += wv * t.x; aS[cc] += wv * t.y; }
            }
            const float sc = 1.0f / 1024.0f;
            u32x4 oc, os;
            oc.x = pk2(aC[0] * sc, aC[1] * sc); oc.y = pk2(aC[2] * sc, aC[3] * sc); oc.z = pk2(aC[4] * sc, aC[5] * sc); oc.w = pk2(aC[6] * sc, aC[7] * sc);
            os.x = pk2(-aS[0] * sc, -aS[1] * sc); os.y = pk2(-aS[2] * sc, -aS[3] * sc); os.z = pk2(-aS[4] * sc, -aS[5] * sc); os.w = pk2(-aS[6] * sc, -aS[7] * sc);
            bf16_t* mt = WSP(bf16_t, WS_MT);
            *(u32x4*)(mt + (size_t)o * 512 + g * 128 + c0) = oc;
            *(u32x4*)(mt + (size_t)(512 + o) * 512 + g * 128 + c0) = os;
            continue;
        } r -= I_MT;
        if (r < I_MOD) {
            const int nb = r >> 3, kb = r & 7, n = 64 * nb + lane;
            float sv[3][2];
#pragma unroll
            for (int rr = 0; rr < 3; ++rr) { const float* cv = rr < 2 ? args.in[1] + rr * DM : args.in[3];
#pragma unroll
                for (int q = 0; q < 2; ++q) { const float v = cv[128 * kb + 64 * q + lane]; sv[rr][q] = v / (1.0f + __expf(-v)); } }
            float acc[3] = {0.f, 0.f, 0.f};
            const float* wp = w_ada + (size_t)(128 * kb) * 3072 + n;
#pragma unroll
            for (int kk = 0; kk < 128; ++kk) {
                const float wv = wp[(size_t)kk * 3072];
#pragma unroll
                for (int rr = 0; rr < 3; ++rr) acc[rr] += wv * __uint_as_float(__builtin_amdgcn_readlane(__float_as_uint(sv[rr][kk >> 6]), kk & 63));
            }
            float* mp = WSP(float, WS_MODP) + (size_t)kb * 3 * 3072 + n;
#pragma unroll
            for (int rr = 0; rr < 3; ++rr) mp[rr * 3072] = acc[rr];
            continue;
        } r -= I_MOD;
        if (r < I_REST) { transpose_item(w_in + 512, 2048, WSP(bf16_t, WS_WREST), DM, scr, r / 48, r % 48, lane); continue; } r -= I_REST;
        if (r < I_OUT) { transpose_item(w_out, DM, WSP(bf16_t, WS_WOUT), DM, scr, r / 32, r % 32, lane); continue; } r -= I_OUT;
        if (r < I_G) { const int mi = r >> 3, q = r & 7, dir = mi >> 3, gate = (mi >> 2) & 1, h = mi & 3;
          const float* src = (gate ? w_ig : w_rg) + ((size_t)dir * 4 + h) * 16384;
          transpose_item(src, 128, WSP(bf16_t, WS_WG) + (size_t)mi * 16384, 128, scr, q >> 2, q & 3, lane); continue; } r -= I_G;
        {
            const f32x4* src = (const f32x4*)(w_in + (size_t)r * 2048) + 2 * lane; const f32x4 v0 = src[0], v1 = src[1];
            u32x4 o; o.x = pk2(v0[0], v0[1]); o.y = pk2(v0[2], v0[3]); o.z = pk2(v1[0], v1[1]); o.w = pk2(v1[2], v1[3]);
            *(u32x4*)(WSP(bf16_t, WS_WINF) + (size_t)r * 512 + 8 * lane) = o;
        }
    }
}

constexpr int CW_HXROW = 64;
__device__ __forceinline__ void p0b_fold_hx(Frame& F, const Args& args) {
    if (F.bid < 16) { SchedFold S{F.G, F.bid, F.ws}; pg8::EpiBf16 E; pg8::gemm_phase<pg8::PAT_PERM, pg8::PAT_PERM>(F.lds, 512, S, E); }
    __syncthreads();
    LAS float* Sv = (LAS float*)F.lds; LAS float* Sh = Sv + 3072;
    const float* modp = WSP(const float, WS_MODP); const float* b_ada = args.in[5]; const float* g = args.in[6];
    for (int i = F.tid; i < 3 * 3072; i += NWAVES * 64) {
        const int rr = i / 3072, n = i % 3072; float v = b_ada[n];
#pragma unroll
        for (int kb = 0; kb < 8; ++kb) v += modp[(size_t)kb * 9216 + i];
        if (n < 1024) Sh[rr * 1024 + n] = v; else if (n < 2048) Sv[rr * 1024 + (n - 1024)] = g[n - 1024] * (1.0f + v);
        if (F.bid == 0) WSP(float, WS_MOD)[i] = v;
    }
    __syncthreads();
    const float* x = args.in[0]; const float* ctx = args.in[2]; bf16_t* hx = WSP(bf16_t, WS_HX);
    for (;;) {
        int row0 = 0; if (F.lane == 0) row0 = (int)atomicAdd(F.ctl + CW_HXROW, 4u);
        row0 = __builtin_amdgcn_readfirstlane(row0);
        if (row0 >= MTOT) break;
#pragma unroll
        for (int q = 0; q < 4; ++q) {
            const int row = row0 + q; const float* xr; int mr;
            if (row < MLAT) { xr = x + (size_t)row * DM; mr = row / TT; } else { xr = ctx + (size_t)(row - MLAT) * DM; mr = 2; }
            const f32x4* xp = (const f32x4*)xr + F.lane; f32x4 v[4]; float s = 0.f;
#pragma unroll
            for (int j = 0; j < 4; ++j) { v[j] = xp[64 * j]; s += (v[j][0] * v[j][0] + v[j][1] * v[j][1]) + (v[j][2] * v[j][2] + v[j][3] * v[j][3]); }
            const float rstd = rsqrtf(wave_sum(s) * (1.0f / DM) + 1e-6f);
            u32x2* o8 = (u32x2*)(hx + (size_t)row * DM) + F.lane;
#pragma unroll
            for (int j = 0; j < 4; ++j) { const f32x4 sc = *(const LAS f32x4*)(Sv + mr * 1024 + 256 * j + 4 * F.lane), sh = *(const LAS f32x4*)(Sh + mr * 1024 + 256 * j + 4 * F.lane);
                const f32x4 h = v[j] * rstd * sc + sh; u32x2 w; w.x = pk2(h[0], h[1]); w.y = pk2(h[2], h[3]); o8[64 * j] = w; }
        }
    }
}

__device__ __forceinline__ void p5_final(Frame& F, const Args& args) {
    const int gw = F.vcu * NWAVES + F.wave, NGW = F.G * NWAVES; const float* fg = args.in[17];
    f32x4 gv[4];
#pragma unroll
    for (int j = 0; j < 4; ++j) gv[j] = ((const f32x4*)fg)[64 * j + F.lane];
    for (int row = gw; row < MLAT; row += NGW) {
        f32x4* xp = (f32x4*)(args.out + (size_t)row * DM) + F.lane; f32x4 v[4]; float s = 0.f;
#pragma unroll
        for (int j = 0; j < 4; ++j) { v[j] = xp[64 * j]; s += (v[j][0] * v[j][0] + v[j][1] * v[j][1]) + (v[j][2] * v[j][2] + v[j][3] * v[j][3]); }
        const float rstd = rsqrtf(wave_sum(s) * (1.0f / DM) + 1e-6f);
#pragma unroll
        for (int j = 0; j < 4; ++j) xp[64 * j] = v[j] * rstd * gv[j];
    }
}

constexpr int FFT_F1_OFF = 0, FFT_TW_OFF = 65536;
__device__ __forceinline__ int crow(int reg, int h) { return (reg & 3) + 8 * (reg >> 2) + 4 * h; }
#define MFMA32(a, b, c) __builtin_amdgcn_mfma_f32_32x32x16_bf16((a), (b), (c), 0, 0, 0)
__device__ __forceinline__ bf16x8 neg8(bf16x8 v) { u32x4 u = __builtin_bit_cast(u32x4, v); u ^= 0x80008000u; return __builtin_bit_cast(bf16x8, u); }

__device__ __forceinline__ void fft_tables(Frame& F) {
    LAS f32x2* cs128 = (LAS f32x2*)(F.lds + MISC_CS128_OFF);
    for (int e = F.tid; e < 64 * 64; e += NWAVES * 64) {
        const int f = e >> 6, lane = e & 63, r = lane & 31, hh = lane >> 5, plane = f & 1, s = (f >> 1) & 1, j = (f >> 2) & 3, mt = f >> 4;
        const int k1 = 32 * mt + r; float v[8];
#pragma unroll
        for (int jj = 0; jj < 8; ++jj) { const int n1 = 32 * j + 16 * s + 8 * (jj >> 2) + 4 * hh + (jj & 3); const f32x2 t = cs128[(k1 * n1) & 127]; v[jj] = plane ? t.y : t.x; }
        u32x4 o; o.x = pk2(v[0], v[1]); o.y = pk2(v[2], v[3]); o.z = pk2(v[4], v[5]); o.w = pk2(v[6], v[7]);
        *(LAS u32x4*)(F.lds + FFT_F1_OFF + e * 16) = o;
    }
    for (int e = F.tid; e < 64 * 64; e += NWAVES * 64) {
        const int lane = e & 63, q = (e >> 6) & 7, h = (e >> 9) & 1, j = e >> 10, r = lane & 31, hh = lane >> 5, k2 = 32 * h + r;
        f32x4 o;
        { const int n1 = 32 * j + crow(2 * q, hh); float sv, cv; sincospif((float)(n1 * k2) * (1.0f / 4096.0f), &sv, &cv); o[0] = cv; o[1] = sv; }
        { const int n1 = 32 * j + crow(2 * q + 1, hh); float sv, cv; sincospif((float)(n1 * k2) * (1.0f / 4096.0f), &sv, &cv); o[2] = cv; o[3] = sv; }
        *(LAS f32x4*)(F.lds + FFT_TW_OFF + e * 16) = o;
    }
}

__device__ __forceinline__ void fft_task(Frame& F, int bt) {
    LAS f32x2* cs128 = (LAS f32x2*)(F.lds + MISC_CS128_OFF);
    const int lane = F.lane, r = lane & 31, hh = lane >> 5, w = F.wave, h = w & 1;
    const int col = bt * 4 + (w >> 1), b = col >> 9, chan = col & 511;
    const bf16_t* zr = WSP(const bf16_t, WS_ZT) + (size_t)chan * MLAT + (size_t)b * TT;
    const bf16_t* zi = zr + (size_t)512 * MLAT;
    bf16x8 c2[4], s2[4];
#pragma unroll
    for (int s = 0; s < 4; ++s) { float cv[8], sv[8];
#pragma unroll
        for (int jj = 0; jj < 8; ++jj) { const int n2 = 16 * s + 8 * hh + jj, k2 = 32 * h + r; const f32x2 t = cs128[(2 * n2 * k2) & 127]; cv[jj] = t.x; sv[jj] = t.y; }
        u32x4 oc, os; oc.x = pk2(cv[0], cv[1]); oc.y = pk2(cv[2], cv[3]); oc.z = pk2(cv[4], cv[5]); oc.w = pk2(cv[6], cv[7]);
        os.x = pk2(sv[0], sv[1]); os.y = pk2(sv[2], sv[3]); os.z = pk2(sv[4], sv[5]); os.w = pk2(sv[6], sv[7]);
        c2[s] = __builtin_bit_cast(bf16x8, oc); s2[s] = __builtin_bit_cast(bf16x8, os); }
    f32x16 X[4];
#pragma unroll
    for (int mt = 0; mt < 4; ++mt)
#pragma unroll
        for (int i = 0; i < 16; ++i) X[mt][i] = 0.f;
#pragma unroll 1
    for (int j = 0; j < 4; ++j) {
        f32x16 Tr, Ti;
#pragma unroll
        for (int i = 0; i < 16; ++i) { Tr[i] = 0.f; Ti[i] = 0.f; }
        const size_t rowoff = (size_t)(32 * j + r) * 64 + 8 * hh;
#pragma unroll
        for (int s = 0; s < 4; ++s) {
            const bf16x8 ar = *(const bf16x8*)(zr + rowoff + 16 * s), ai = *(const bf16x8*)(zi + rowoff + 16 * s);
            const bf16x8 arn = neg8(ar);
            Tr = MFMA32(ar, c2[s], Tr); Tr = MFMA32(ai, s2[s], Tr);
            Ti = MFMA32(ai, c2[s], Ti); Ti = MFMA32(arn, s2[s], Ti);
        }
        u32x4 pr[2], pi[2];
#pragma unroll
        for (int q = 0; q < 8; ++q) {
            const f32x4 tw = *(const LAS f32x4*)(F.lds + FFT_TW_OFF + ((((j * 2 + h) * 8 + q) * 64 + lane) * 16));
            const float tr0 = Tr[2 * q], ti0 = Ti[2 * q], tr1 = Tr[2 * q + 1], ti1 = Ti[2 * q + 1];
            const float r0 = tr0 * tw[0] + ti0 * tw[1], i0 = ti0 * tw[0] - tr0 * tw[1];
            const float r1 = tr1 * tw[2] + ti1 * tw[3], i1 = ti1 * tw[2] - tr1 * tw[3];
            pr[q >> 2][q & 3] = pk2(r0, r1); pi[q >> 2][q & 3] = pk2(i0, i1);
        }
#pragma unroll
        for (int mt = 0; mt < 4; ++mt)
#pragma unroll
            for (int s = 0; s < 2; ++s) {
                const bf16x8 fc = *(const LAS bf16x8*)(F.lds + FFT_F1_OFF + ((((mt * 4 + j) * 2 + s) * 2 + 0) * 64 + lane) * 16);
                const bf16x8 fs = *(const LAS bf16x8*)(F.lds + FFT_F1_OFF + ((((mt * 4 + j) * 2 + s) * 2 + 1) * 64 + lane) * 16);
                X[mt] = MFMA32(fc, __builtin_bit_cast(bf16x8, pr[s]), X[mt]);
                X[mt] = MFMA32(fs, __builtin_bit_cast(bf16x8, pi[s]), X[mt]);
            }
    }
    bf16_t* yo = WSP(bf16_t, WS_YFT) + ((size_t)b * 512 + chan) * TT + 32 * h + r;
#pragma unroll
    for (int mt = 0; mt < 4; ++mt)
#pragma unroll
        for (int i = 0; i < 16; ++i) { const int k1 = 32 * mt + crow(i, hh); yo[64 * k1] = f2bf(X[mt][i]); }
}
#define MFMA16(a, b, c) __builtin_amdgcn_mfma_f32_16x16x32_bf16((a), (b), (c), 0, 0, 0)
constexpr int LRU_V_OFF = 0, LRU_V_PITCH = 272;
constexpr int LRU_HB_OFF = 36864, LRU_HB_PITCH = 528;
constexpr int NCI = 66;
__device__ __forceinline__ size_t sum_idx(int b, int ci, int dir, int ch) { return ((((size_t)b * NCI + ci) * 2 + dir) * 512 + ch); }

__device__ __forceinline__ void lru_conv_to_lds(Frame& F, const Args& args, int b, int ci, int hd) {
    const bf16_t* ul = WSP(const bf16_t, WS_UL); const float* conv_w = args.in[9]; const float* conv_b = args.in[10];
    const int c8 = F.tid & 15, tg = F.tid >> 4, ch0 = hd * 128 + 8 * c8;
    int L, t0; size_t rbase;
    if (ci < 2) { L = CTXL; t0 = 128 * ci; rbase = (size_t)MLAT + (size_t)b * CTXL; } else { L = TT; t0 = 128 * (ci - 2); rbase = (size_t)b * TT; }
    float in[7][8];
#pragma unroll
    for (int q = 0; q < 7; ++q) { const int t = t0 + 4 * tg - 2 + q;
        if (t >= 0 && t < L) { const u32x4 v = *(const u32x4*)(ul + (rbase + t) * 512 + ch0);
#pragma unroll
            for (int i = 0; i < 4; ++i) { in[q][2 * i] = __uint_as_float(v[i] << 16); in[q][2 * i + 1] = __uint_as_float(v[i] & 0xffff0000u); } }
        else {
#pragma unroll
            for (int i = 0; i < 8; ++i) in[q][i] = 0.f; } }
    float cw[4][8], cb[8];
#pragma unroll
    for (int j = 0; j < 4; ++j) { const f32x4 a = *(const f32x4*)(conv_w + j * 512 + ch0), c = *(const f32x4*)(conv_w + j * 512 + ch0 + 4);
#pragma unroll
        for (int i = 0; i < 4; ++i) { cw[j][i] = a[i]; cw[j][4 + i] = c[i]; } }
    { const f32x4 a = *(const f32x4*)(conv_b + ch0), c = *(const f32x4*)(conv_b + ch0 + 4);
#pragma unroll
      for (int i = 0; i < 4; ++i) { cb[i] = a[i]; cb[4 + i] = c[i]; } }
#pragma unroll
    for (int q = 0; q < 4; ++q) { float v[8];
#pragma unroll
        for (int i = 0; i < 8; ++i) v[i] = cb[i] + cw[0][i] * in[q][i] + cw[1][i] * in[q + 1][i] + cw[2][i] * in[q + 2][i] + cw[3][i] * in[q + 3][i];
        u32x4 o; o.x = pk2(v[0], v[1]); o.y = pk2(v[2], v[3]); o.z = pk2(v[4], v[5]); o.w = pk2(v[6], v[7]);
        *(LAS u32x4*)(F.lds + LRU_V_OFF + (4 * tg + q) * LRU_V_PITCH + c8 * 16) = o; }
}

__device__ __forceinline__ void lru_tile_gates(Frame& F, int s, const bf16x8 (&Brg)[4], const bf16x8 (&Big)[4], float brg, float big, float c8v, float (&a)[4], float (&bx)[4]) {
    const int lane = F.lane, g = lane >> 4, e = lane & 15;
    f32x4 arg = {0.f, 0.f, 0.f, 0.f}, aig = {0.f, 0.f, 0.f, 0.f};
#pragma unroll
    for (int ks = 0; ks < 4; ++ks) {
        const bf16x8 av = *(const LAS bf16x8*)(F.lds + LRU_V_OFF + (16 * s + e) * LRU_V_PITCH + (32 * ks + 8 * g) * 2);
        arg = MFMA16(av, Brg[ks], arg); aig = MFMA16(av, Big[ks], aig);
    }
#pragma unroll
    for (int i = 0; i < 4; ++i) {
        const float vv = bf2f(*(const LAS bf16_t*)(F.lds + LRU_V_OFF + (16 * s + 4 * g + i) * LRU_V_PITCH + (16 * F.wave + e) * 2));
        const float rr = fsigm(arg[i] + brg), ii = fsigm(aig[i] + big);
        const float la = -c8v * rr, av = __expf(la), x2 = 2.0f * la;
        const float om = (x2 > -0.02f) ? (-x2 * (1.0f + x2 * (0.5f + x2 * (0.16666667f + x2 * 0.041666668f)))) : (1.0f - av * av);
        a[i] = av; bx[i] = sqrtf(om) * (ii * vv);
    }
}

template <int PASS>
__device__ __forceinline__ void lru_task(Frame& F, const Args& args, int task) {
    const int hd = task & 3, rest = task >> 2;
    int b, ci;
    if (PASS == 1) { b = rest / NCI; ci = rest % NCI; } else { b = rest >> 6; ci = 2 + (rest & 63); }
    const int lane = F.lane, g = lane >> 4, e = lane & 15, w = F.wave, ch = hd * 128 + 16 * w + e;
    __syncthreads();
    lru_conv_to_lds(F, args, b, ci, hd);
    const float* b_rg = args.in[12]; const float* b_ig = args.in[14]; const float* lam = args.in[15];
    float cinf = 0.f, cinb = 0.f;
    if (PASS == 2) {
        const float2* sum = WSP(const float2, WS_SUM);
        float hf = 0.f;
        for (int cj = 0; cj < ci; ++cj) { const float2 t = sum[sum_idx(b, cj, 0, ch)]; hf = t.x * hf + t.y; }
        float hb = 0.f;
        { const float2 t1 = sum[sum_idx(b, 1, 1, ch)]; hb = t1.x * hb + t1.y; const float2 t0 = sum[sum_idx(b, 0, 1, ch)]; hb = t0.x * hb + t0.y; }
        for (int cj = NCI - 1; cj > ci; --cj) { const float2 t = sum[sum_idx(b, cj, 1, ch)]; hb = t.x * hb + t.y; }
        cinf = hf; cinb = hb;
    }
    __syncthreads();
#pragma unroll 1
    for (int sw = 0; sw < 2; ++sw) {
        const int dir = 1 - sw;
        bf16x8 Brg[4], Big[4];
        { const bf16_t* wg = WSP(const bf16_t, WS_WG) + ((size_t)(dir * 2 + 0) * 4 + hd) * 16384 + (size_t)(16 * w + e) * 128 + 8 * g;
#pragma unroll
          for (int ks = 0; ks < 4; ++ks) { Brg[ks] = *(const bf16x8*)(wg + 32 * ks); Big[ks] = *(const bf16x8*)(wg + (size_t)4 * 16384 + 32 * ks); } }
        const float brg = b_rg[dir * 512 + ch], big = b_ig[dir * 512 + ch];
        const float lv = lam[dir * 512 + ch]; const float c8v = 8.0f * (fmaxf(-lv, 0.f) + log1pf(__expf(-fabsf(lv))));
        float hin = (PASS == 2) ? (dir ? cinb : cinf) : 0.f, aprod = 1.0f;
#pragma unroll 1
        for (int st = 0; st < 8; ++st) {
            const int s = dir ? 7 - st : st;
            float a[4], bx[4];
            lru_tile_gates(F, s, Brg, Big, brg, big, c8v, a, bx);
            float A4 = (a[0] * a[1]) * (a[2] * a[3]);
            float B4 = dir ? (((bx[3] * a[2] + bx[2]) * a[1] + bx[1]) * a[0] + bx[0]) : (((bx[0] * a[1] + bx[1]) * a[2] + bx[2]) * a[3] + bx[3]);
            float Ag[4], Bg[4];
#pragma unroll
            for (int gg = 0; gg < 4; ++gg) { Ag[gg] = __shfl(A4, 16 * gg + e); Bg[gg] = __shfl(B4, 16 * gg + e); }
            float P0 = hin, P1, P2, P3, P4;
            if (dir) { P1 = Ag[3] * P0 + Bg[3]; P2 = Ag[2] * P1 + Bg[2]; P3 = Ag[1] * P2 + Bg[1]; P4 = Ag[0] * P3 + Bg[0]; }
            else     { P1 = Ag[0] * P0 + Bg[0]; P2 = Ag[1] * P1 + Bg[1]; P3 = Ag[2] * P2 + Bg[2]; P4 = Ag[3] * P3 + Bg[3]; }
            if (PASS == 1) aprod *= (Ag[0] * Ag[1]) * (Ag[2] * Ag[3]);
            if (PASS == 2) {
                const int go = dir ? 3 - g : g;
                float hcur = go == 0 ? P0 : (go == 1 ? P1 : (go == 2 ? P2 : P3));
                LAS float* hbp = (LAS float*)(F.lds + LRU_HB_OFF + (16 * s + 4 * g) * LRU_HB_PITCH + (16 * w + e) * 4);
                if (dir) {
#pragma unroll
                    for (int i = 3; i >= 0; --i) { hcur = a[i] * hcur + bx[i]; hbp[i * (LRU_HB_PITCH / 4)] = hcur; }
                } else {
#pragma unroll
                    for (int i = 0; i < 4; ++i) { hcur = a[i] * hcur + bx[i]; hbp[i * (LRU_HB_PITCH / 4)] += hcur; }
                }
            }
            hin = P4;
        }
        if (PASS == 1 && g == 0) WSP(float2, WS_SUM)[sum_idx(b, ci, dir, ch)] = make_float2(aprod, hin);
    }
    if (PASS == 2) {
        __syncthreads();
        const int c8 = F.tid & 15, tg = F.tid >> 4; const size_t row0 = (size_t)b * TT + 128 * (ci - 2) + 4 * tg;
        const bf16_t* gl = WSP(const bf16_t, WS_GL); bf16_t* y = WSP(bf16_t, WS_Y);
#pragma unroll
        for (int q = 0; q < 4; ++q) {
            const LAS f32x4* hp = (const LAS f32x4*)(F.lds + LRU_HB_OFF + (4 * tg + q) * LRU_HB_PITCH + c8 * 32);
            const f32x4 h0 = hp[0], h1 = hp[1];
            const u32x4 gv = *(const u32x4*)(gl + (row0 + q) * 512 + hd * 128 + 8 * c8);
            u32x4 o;
            o.x = pk2(h0[0] * __uint_as_float(gv.x << 16), h0[1] * __uint_as_float(gv.x & 0xffff0000u));
            o.y = pk2(h0[2] * __uint_as_float(gv.y << 16), h0[3] * __uint_as_float(gv.y & 0xffff0000u));
            o.z = pk2(h1[0] * __uint_as_float(gv.z << 16), h1[1] * __uint_as_float(gv.z & 0xffff0000u));
            o.w = pk2(h1[2] * __uint_as_float(gv.w << 16), h1[3] * __uint_as_float(gv.w & 0xffff0000u));
            *(u32x4*)(y + (row0 + q) * DM + 512 + hd * 128 + 8 * c8) = o;
        }
    }
}

constexpr int FT_PITCH = 260;
__device__ __forceinline__ void fourier_gate_task(Frame& F, int task) {
    const int hd = task & 3, rest = task >> 2, b = rest >> 6, c = rest & 63;
    __syncthreads();
    { const int chan = F.tid >> 2, seg = F.tid & 3;
      const bf16_t* src = WSP(const bf16_t, WS_YFT) + ((size_t)b * 512 + hd * 128 + chan) * TT + 128 * c + 32 * seg;
#pragma unroll
      for (int q = 0; q < 4; ++q) { const u32x4 v = *(const u32x4*)(src + 8 * q);
          LAS unsigned* dst = (LAS unsigned*)(F.lds + chan * FT_PITCH + (32 * seg + 8 * q) * 2);
          dst[0] = v.x; dst[1] = v.y; dst[2] = v.z; dst[3] = v.w; } }
    __syncthreads();
    { const int tok = F.tid & 127, cq = F.tid >> 7; const size_t row = (size_t)b * TT + 128 * c + tok;
      const bf16_t* gf = WSP(const bf16_t, WS_GF); bf16_t* y = WSP(bf16_t, WS_Y);
#pragma unroll
      for (int c8 = 0; c8 < 4; ++c8) { const int ch0 = 32 * cq + 8 * c8; float v[8];
#pragma unroll
          for (int i = 0; i < 8; ++i) v[i] = bf2f(*(const LAS bf16_t*)(F.lds + (ch0 + i) * FT_PITCH + tok * 2));
          const u32x4 gv = *(const u32x4*)(gf + row * 512 + hd * 128 + ch0);
          u32x4 o;
          o.x = pk2(v[0] * __uint_as_float(gv.x << 16), v[1] * __uint_as_float(gv.x & 0xffff0000u));
          o.y = pk2(v[2] * __uint_as_float(gv.y << 16), v[3] * __uint_as_float(gv.y & 0xffff0000u));
          o.z = pk2(v[4] * __uint_as_float(gv.z << 16), v[5] * __uint_as_float(gv.z & 0xffff0000u));
          o.w = pk2(v[6] * __uint_as_float(gv.w << 16), v[7] * __uint_as_float(gv.w & 0xffff0000u));
          *(u32x4*)(y + row * DM + hd * 128 + ch0) = o; } }
}
__global__ void __launch_bounds__(NWAVES * 64, 2) mk_fwd(Args args) {
    extern __shared__ __attribute__((aligned(16))) unsigned char lds_raw[];
    Frame F;
    F.lds = (LAS unsigned char*)lds_raw;
    F.MISC = (volatile LAS unsigned*)(F.lds + MISC_OFF);
    F.tid = threadIdx.x; F.lane = F.tid & 63; F.wave = __builtin_amdgcn_readfirstlane(F.tid >> 6);
    F.G = gridDim.x; F.bid = blockIdx.x; F.vcu = (F.G % 8 == 0) ? (F.bid % 8) * (F.G / 8) + F.bid / 8 : F.bid;
    F.ws = args.ws; F.ctl = (unsigned*)(args.ws + WS_CTL);
    if (F.tid < 32) F.MISC[F.tid] = 0u;
    if (F.tid >= 64 && F.tid < 192) { const int i = F.tid - 64; float sv, cv; sincospif((float)i * (1.0f / 64.0f), &sv, &cv); ((LAS f32x2*)(F.lds + MISC_CS128_OFF))[i] = (f32x2){cv, sv}; }
    __syncthreads();
    const int lo = args.ph_lo, hi = args.ph_hi;
    XcdBarrier bar; bar.bar = F.ctl + 1024; bar.x = 0; bar.st = nullptr;
    if (hi - lo > 1) bar = xcd_barrier_post(F.ctl + 1024, F.MISC + 8);
#define IN(k) (lo <= (k) && (k) < hi)
#define SEAM(k) do { if (IN(k) && IN((k) + 1)) xcd_barrier(bar); } while (0)

    if (IN(0)) { p0_prep(F, args); }
    SEAM(0);
    if (IN(1)) { p0b_fold_hx(F, args); }
    SEAM(1);
    if (IN(2)) {
        SchedP1 S{F.G, F.bid, F.ws}; pg8::EpiBf16 E;
        pg8::gemm_phase<pg8::PAT_PERM, pg8::PAT_FFT>(F.lds, DM, S, E);
    }
    SEAM(2);
    if (IN(3)) {
        fft_tables(F); __syncthreads();
        for (int bt = F.bid; bt < 256; bt += F.G) fft_task(F, bt);
        for (int task = F.bid; task < 528; task += F.G) lru_task<1>(F, args, task);
    }
    SEAM(3);
    if (IN(4)) { for (int task = F.bid; task < 512; task += F.G) { fourier_gate_task(F, task); lru_task<2>(F, args, task); } }
    SEAM(4);
    if (IN(5)) {
        SchedP4 S{F.G, F.bid, F.ws}; pg8::EpiOutF32 E{args.in[0], args.out, WSP(const float, WS_MOD)};
        pg8::gemm_phase<pg8::PAT_NAT, pg8::PAT_NAT>(F.lds, DM, S, E);
    }
    SEAM(5);
    if (IN(6)) { p5_final(F, args); }
#undef IN
#undef SEAM
}

static int g_grid = 0;
static void mk_launch(const Args& base, int lo, int hi, hipStream_t stream) {
    Args a = base; a.ph_lo = lo; a.ph_hi = hi;
    hipLaunchKernelGGL(mk_fwd, dim3(g_grid), dim3(NWAVES * 64), LDS_BYTES, stream, a);
}
extern "C" void kernel_launch(void* const* d_in, const int* in_sizes, int n_in, void* d_out, int out_size, void* d_ws, size_t ws_size, hipStream_t stream) {
    if (g_grid == 0) {
        int dev = 0, cus = 0, per_cu = 0;
        (void)hipGetDevice(&dev); (void)hipDeviceGetAttribute(&cus, hipDeviceAttributeMultiprocessorCount, dev);
        (void)hipFuncSetAttribute((const void*)mk_fwd, hipFuncAttributeMaxDynamicSharedMemorySize, LDS_BYTES);
        (void)hipOccupancyMaxActiveBlocksPerMultiprocessor(&per_cu, (const void*)mk_fwd, NWAVES * 64, LDS_BYTES);
        (void)hipGetLastError();
        g_grid = cus > 0 ? cus : 256;
    }
    (void)hipMemsetAsync((char*)d_ws + WS_CTL, 0, CTL_ZERO_BYTES, stream);
    Args a{}; for (int i = 0; i < 18; ++i) a.in[i] = (const float*)d_in[i]; a.out = (float*)d_out; a.ws = (unsigned char*)d_ws;
    mk_launch(a, 0, 7, stream);
}
```

```cpp
#include <hip/hip_runtime.h>
#include <stdint.h>

typedef unsigned short bf16_t;

#define NB 2
#define TT 8192
#define DM 1024
#define CTXL 256
#define MLAT (NB * TT)
#define MCTX (NB * CTXL)
#define MTOT (MLAT + MCTX)
#define DF 512
#define DL 512
#define HD 128

__device__ __forceinline__ float bf2f(bf16_t b) { return __uint_as_float(((unsigned)b) << 16); }
__device__ __forceinline__ bf16_t f2bf(float f) { unsigned u = __float_as_uint(f); u += 0x7fffu + ((u >> 16) & 1u); return (bf16_t)(u >> 16); }
__device__ __forceinline__ float siluf(float v) { return v / (1.0f + expf(-v)); }
__device__ __forceinline__ float sigmf(float v) { return 1.0f / (1.0f + expf(-v)); }

constexpr size_t MiB = 1u << 20;
constexpr size_t WS_CTL = 0, CTL_ZERO_BYTES = 256 * 1024;
constexpr size_t WS_MODP = 512 * 1024;
constexpr size_t WS_MOD = 1 * MiB;
constexpr size_t WS_SUM = 1 * MiB + 64 * 1024;
constexpr size_t WS_WREST = 3 * MiB;
constexpr size_t WS_WFOLD = 6 * MiB;
constexpr size_t WS_WOUT = 8 * MiB;
constexpr size_t WS_WG = 10 * MiB;
constexpr size_t WS_MT = 11 * MiB;
constexpr size_t WS_WINF = 13 * MiB;
constexpr size_t WS_HX = 16 * MiB;
constexpr size_t WS_ZT = 50 * MiB;
constexpr size_t WS_GF = 82 * MiB;
constexpr size_t WS_UL = 98 * MiB;
constexpr size_t WS_GL = 115 * MiB;
constexpr size_t WS_YFT = 131 * MiB;
constexpr size_t WS_Y = 147 * MiB;
constexpr size_t WS_HF = 179 * MiB;
constexpr size_t WS_HB = 211 * MiB;

#ifndef PROBE_REP
#define PROBE_REP -1
#endif
#define LAS __attribute__((address_space(3)))
typedef short bf16x8 __attribute__((ext_vector_type(8)));
typedef float f32x4 __attribute__((ext_vector_type(4)));
typedef float f32x2 __attribute__((ext_vector_type(2)));
typedef float f32x16 __attribute__((ext_vector_type(16)));
typedef unsigned u32x4 __attribute__((ext_vector_type(4)));
typedef unsigned u32x2 __attribute__((ext_vector_type(2)));
typedef __bf16 bf16x2_t __attribute__((ext_vector_type(2)));
#define LDS_WAIT() asm volatile("s_waitcnt lgkmcnt(0)" ::: "memory")
#define VM_WAIT() asm volatile("s_waitcnt vmcnt(0)" ::: "memory")

__device__ __forceinline__ unsigned pk2(float a, float b) { f32x2 v = {a, b}; bf16x2_t r = __builtin_convertvector(v, bf16x2_t); return __builtin_bit_cast(unsigned, r); }
__device__ __forceinline__ float fsilu(float v) { return v * __builtin_amdgcn_rcpf(1.0f + __expf(-v)); }
__device__ __forceinline__ float fsigm(float v) { return __builtin_amdgcn_rcpf(1.0f + __expf(-v)); }

__constant__ float2 CS128C[128] = {{1.000000000e+00f, 0.000000000e+00f}, {9.987954562e-01f, 4.906767433e-02f}, {9.951847267e-01f, 9.801714033e-02f}, {9.891765100e-01f, 1.467304745e-01f}, {9.807852804e-01f, 1.950903220e-01f}, {9.700312532e-01f, 2.429801799e-01f}, {9.569403357e-01f, 2.902846773e-01f}, {9.415440652e-01f, 3.368898534e-01f}, {9.238795325e-01f, 3.826834324e-01f}, {9.039892931e-01f, 4.275550934e-01f}, {8.819212643e-01f, 4.713967368e-01f}, {8.577286100e-01f, 5.141027442e-01f}, {8.314696123e-01f, 5.555702330e-01f}, {8.032075315e-01f, 5.956993045e-01f}, {7.730104534e-01f, 6.343932842e-01f}, {7.409511254e-01f, 6.715589548e-01f}, {7.071067812e-01f, 7.071067812e-01f}, {6.715589548e-01f, 7.409511254e-01f}, {6.343932842e-01f, 7.730104534e-01f}, {5.956993045e-01f, 8.032075315e-01f}, {5.555702330e-01f, 8.314696123e-01f}, {5.141027442e-01f, 8.577286100e-01f}, {4.713967368e-01f, 8.819212643e-01f}, {4.275550934e-01f, 9.039892931e-01f}, {3.826834324e-01f, 9.238795325e-01f}, {3.368898534e-01f, 9.415440652e-01f}, {2.902846773e-01f, 9.569403357e-01f}, {2.429801799e-01f, 9.700312532e-01f}, {1.950903220e-01f, 9.807852804e-01f}, {1.467304745e-01f, 9.891765100e-01f}, {9.801714033e-02f, 9.951847267e-01f}, {4.906767433e-02f, 9.987954562e-01f}, {6.123233996e-17f, 1.000000000e+00f}, {-4.906767433e-02f, 9.987954562e-01f}, {-9.801714033e-02f, 9.951847267e-01f}, {-1.467304745e-01f, 9.891765100e-01f}, {-1.950903220e-01f, 9.807852804e-01f}, {-2.429801799e-01f, 9.700312532e-01f}, {-2.902846773e-01f, 9.569403357e-01f}, {-3.368898534e-01f, 9.415440652e-01f}, {-3.826834324e-01f, 9.238795325e-01f}, {-4.275550934e-01f, 9.039892931e-01f}, {-4.713967368e-01f, 8.819212643e-01f}, {-5.141027442e-01f, 8.577286100e-01f}, {-5.555702330e-01f, 8.314696123e-01f}, {-5.956993045e-01f, 8.032075315e-01f}, {-6.343932842e-01f, 7.730104534e-01f}, {-6.715589548e-01f, 7.409511254e-01f}, {-7.071067812e-01f, 7.071067812e-01f}, {-7.409511254e-01f, 6.715589548e-01f}, {-7.730104534e-01f, 6.343932842e-01f}, {-8.032075315e-01f, 5.956993045e-01f}, {-8.314696123e-01f, 5.555702330e-01f}, {-8.577286100e-01f, 5.141027442e-01f}, {-8.819212643e-01f, 4.713967368e-01f}, {-9.039892931e-01f, 4.275550934e-01f}, {-9.238795325e-01f, 3.826834324e-01f}, {-9.415440652e-01f, 3.368898534e-01f}, {-9.569403357e-01f, 2.902846773e-01f}, {-9.700312532e-01f, 2.429801799e-01f}, {-9.807852804e-01f, 1.950903220e-01f}, {-9.891765100e-01f, 1.467304745e-01f}, {-9.951847267e-01f, 9.801714033e-02f}, {-9.987954562e-01f, 4.906767433e-02f}, {-1.000000000e+00f, 1.224646799e-16f}, {-9.987954562e-01f, -4.906767433e-02f}, {-9.951847267e-01f, -9.801714033e-02f}, {-9.891765100e-01f, -1.467304745e-01f}, {-9.807852804e-01f, -1.950903220e-01f}, {-9.700312532e-01f, -2.429801799e-01f}, {-9.569403357e-01f, -2.902846773e-01f}, {-9.415440652e-01f, -3.368898534e-01f}, {-9.238795325e-01f, -3.826834324e-01f}, {-9.039892931e-01f, -4.275550934e-01f}, {-8.819212643e-01f, -4.713967368e-01f}, {-8.577286100e-01f, -5.141027442e-01f}, {-8.314696123e-01f, -5.555702330e-01f}, {-8.032075315e-01f, -5.956993045e-01f}, {-7.730104534e-01f, -6.343932842e-01f}, {-7.409511254e-01f, -6.715589548e-01f}, {-7.071067812e-01f, -7.071067812e-01f}, {-6.715589548e-01f, -7.409511254e-01f}, {-6.343932842e-01f, -7.730104534e-01f}, {-5.956993045e-01f, -8.032075315e-01f}, {-5.555702330e-01f, -8.314696123e-01f}, {-5.141027442e-01f, -8.577286100e-01f}, {-4.713967368e-01f, -8.819212643e-01f}, {-4.275550934e-01f, -9.039892931e-01f}, {-3.826834324e-01f, -9.238795325e-01f}, {-3.368898534e-01f, -9.415440652e-01f}, {-2.902846773e-01f, -9.569403357e-01f}, {-2.429801799e-01f, -9.700312532e-01f}, {-1.950903220e-01f, -9.807852804e-01f}, {-1.467304745e-01f, -9.891765100e-01f}, {-9.801714033e-02f, -9.951847267e-01f}, {-4.906767433e-02f, -9.987954562e-01f}, {-1.836970199e-16f, -1.000000000e+00f}, {4.906767433e-02f, -9.987954562e-01f}, {9.801714033e-02f, -9.951847267e-01f}, {1.467304745e-01f, -9.891765100e-01f}, {1.950903220e-01f, -9.807852804e-01f}, {2.429801799e-01f, -9.700312532e-01f}, {2.902846773e-01f, -9.569403357e-01f}, {3.368898534e-01f, -9.415440652e-01f}, {3.826834324e-01f, -9.238795325e-01f}, {4.275550934e-01f, -9.039892931e-01f}, {4.713967368e-01f, -8.819212643e-01f}, {5.141027442e-01f, -8.577286100e-01f}, {5.555702330e-01f, -8.314696123e-01f}, {5.956993045e-01f, -8.032075315e-01f}, {6.343932842e-01f, -7.730104534e-01f}, {6.715589548e-01f, -7.409511254e-01f}, {7.071067812e-01f, -7.071067812e-01f}, {7.409511254e-01f, -6.715589548e-01f}, {7.730104534e-01f, -6.343932842e-01f}, {8.032075315e-01f, -5.956993045e-01f}, {8.314696123e-01f, -5.555702330e-01f}, {8.577286100e-01f, -5.141027442e-01f}, {8.819212643e-01f, -4.713967368e-01f}, {9.039892931e-01f, -4.275550934e-01f}, {9.238795325e-01f, -3.826834324e-01f}, {9.415440652e-01f, -3.368898534e-01f}, {9.569403357e-01f, -2.902846773e-01f}, {9.700312532e-01f, -2.429801799e-01f}, {9.807852804e-01f, -1.950903220e-01f}, {9.891765100e-01f, -1.467304745e-01f}, {9.951847267e-01f, -9.801714033e-02f}, {9.987954562e-01f, -4.906767433e-02f}};

constexpr int NWAVES = 8;
constexpr int RING_BYTES = 131072;
constexpr int MISC_OFF = 146432;
constexpr int MISC_CS128_OFF = 145408;
constexpr int LDS_BYTES = 147456;

#define XB_TMO      128
#define XB_XCNT(j)  (256  + 64 * (j))
#define XB_XSUB(j)  (1280 + 64 * (j))
#define XB_XGEN(j)  (2304 + 64 * (j))
#define XB_TOP      3328
#define XB_TOPGEN   3392
#define XCD_BAR_WORDS 3456
#define XB_SPIN_CAP (1u << 18)
__device__ __forceinline__ unsigned xb_ld(unsigned* p)              { return __hip_atomic_load(p, __ATOMIC_RELAXED, __HIP_MEMORY_SCOPE_AGENT); }
__device__ __forceinline__ unsigned xb_add(unsigned* p, unsigned v) { return __hip_atomic_fetch_add(p, v, __ATOMIC_RELAXED, __HIP_MEMORY_SCOPE_AGENT); }
__device__ __forceinline__ unsigned xb_xcc_id() { return (unsigned)__builtin_amdgcn_s_getreg((3 << 11) | 20) & 0xFu; }
#define XB_SPIN(cond, bar) do { unsigned _sp = 0; while (cond) { __builtin_amdgcn_s_sleep(1); \
    if ((++_sp & 255u) == 0u) { if (xb_ld(&(bar)[XB_TMO])) break; if (_sp > XB_SPIN_CAP) { atomicAdd(&(bar)[XB_TMO], 1u); break; } } } } while (0)
struct XcdBarrier { unsigned* bar; unsigned x; volatile LAS unsigned* st; };
__device__ __forceinline__ XcdBarrier xcd_barrier_post(unsigned* bar, volatile LAS unsigned* st) {
    XcdBarrier b; b.bar = bar; b.x = xb_xcc_id(); b.st = st;
    if (threadIdx.x == 0) (void)xb_add(&bar[XB_XCNT(b.x)], 1u);
    return b;
}
__device__ __forceinline__ void xcd_barrier_complete(unsigned* bar, unsigned x, unsigned& nloc, unsigned& nx) {
    const unsigned G = gridDim.x * gridDim.y * gridDim.z;
    unsigned sum, cnt, mine, sp = 0u;
    for (;;) {
        sum = 0u; cnt = 0u; mine = 0u;
#pragma unroll
        for (unsigned j = 0; j < 16; ++j) { const unsigned c = xb_ld(&bar[XB_XCNT(j)]); sum += c; cnt += (c > 0u) ? 1u : 0u; mine = (j == x) ? c : mine; }
        if (sum == G) break;
        __builtin_amdgcn_s_sleep(1);
        if ((++sp & 255u) == 0u) { if (xb_ld(&bar[XB_TMO])) break; if (sp > XB_SPIN_CAP) { atomicAdd(&bar[XB_TMO], 1u); break; } }
    }
    nloc = mine > 0u ? mine : 1u; nx = cnt > 0u ? cnt : 1u;
}
__device__ __forceinline__ void xcd_barrier(const XcdBarrier& b) {
    asm volatile("s_waitcnt vmcnt(0)" ::: "memory");
    __syncthreads();
    if (threadIdx.x == 0) {
        unsigned* bar = b.bar;
        __builtin_amdgcn_s_waitcnt(0);
        unsigned nloc = b.st[0], nx = b.st[1];
        if (nloc == 0u) { xcd_barrier_complete(bar, b.x, nloc, nx); b.st[0] = nloc; b.st[1] = nx; }
        const unsigned old = xb_add(&bar[XB_XSUB(b.x)], 1u);
        const unsigned gen = old / nloc;
        if (old + 1u == (gen + 1u) * nloc) {
            __builtin_amdgcn_fence(__ATOMIC_RELEASE, "agent");
            asm volatile("s_waitcnt vmcnt(0)" ::: "memory");
            const unsigned og = xb_add(&bar[XB_TOP], 1u);
            const unsigned tg = og / nx;
            if (og + 1u == (tg + 1u) * nx) xb_add(&bar[XB_TOPGEN], 1u);
            else XB_SPIN(xb_ld(&bar[XB_TOPGEN]) == tg, bar);
            __builtin_amdgcn_fence(__ATOMIC_ACQUIRE, "agent");
            xb_add(&bar[XB_XGEN(b.x)], 1u);
            asm volatile("s_waitcnt vmcnt(0)" ::: "memory");
        } else {
            XB_SPIN(xb_ld(&bar[XB_XGEN(b.x)]) == gen, bar);
            __builtin_amdgcn_fence(__ATOMIC_ACQUIRE, "agent");
            asm volatile("s_waitcnt vmcnt(0)" ::: "memory");
        }
    }
    __syncthreads();
}

namespace pg8 {
constexpr int BM = 256, BK = 64, HALF = 128, HTB = HALF * BK * 2, STAGE_BYTES = 8 * HTB;
__device__ __forceinline__ int lds_byte(int r, int c) { const int st = (r >> 4) * 2 + (c >> 5), rr = r & 15, cc = c & 31, ob = rr * 64 + cc * 2; return st * 1024 + (ob ^ (((ob >> 9) & 1) << 5)); }
__device__ __forceinline__ void stage_rc(int b, int& R, int& C) { const int st = b / 1024, sb = b % 1024, swz = sb ^ (((sb >> 9) & 1) << 5); R = (st >> 1) * 16 + swz / 64; C = (st & 1) * 32 + (swz % 64) / 2; }
__device__ __forceinline__ int perm32(int rho) { const int n = rho >> 4, i = rho & 15; return 8 * (i >> 2) + 4 * n + (i & 3); }

struct Unit { const char* a; const char* b; char* o; int ldc; int flags; int pm; int pn; };

enum { PAT_NAT = 0, PAT_PERM = 1, PAT_FFT = 2 };
template <int PAT> __device__ __forceinline__ int brow(int R) {
    if (PAT == PAT_NAT) return R;
    const int Rb = (R & ~31) + perm32(R & 31);
    if (PAT == PAT_PERM) return Rb;
    return (Rb >> 6) + 128 * (Rb & 63);
}
template <int PAT> __device__ __forceinline__ size_t bhstep(int K) { return PAT == PAT_FFT ? (size_t)2 * K * 2 : (size_t)HALF * K * 2; }

template <int PAT0, int PAT1, class Sched, class Epi>
__device__ __forceinline__ void gemm_phase(LAS unsigned char* lds, const int K, const Sched& S, const Epi& E) {
    const int tid = threadIdx.x, wid = __builtin_amdgcn_readfirstlane(tid >> 6), lane = tid & 63, wr = wid >> 2, wc = wid & 3, fr = lane & 15, fq = lane >> 4;
    const int nt = K / BK;
    unsigned voffA[2], voffB0[2], voffB1[2];
#pragma unroll
    for (int i = 0; i < 2; ++i) { int R, C; stage_rc(tid * 16 + i * 8192, R, C);
        voffA[i] = (unsigned)(R * K + C) * 2u; voffB0[i] = (unsigned)(brow<PAT0>(R) * K + C) * 2u; voffB1[i] = (unsigned)(brow<PAT1>(R) * K + C) * 2u; }
    const size_t kstep = (size_t)(BK * 2);
    const size_t hstepA = (size_t)HALF * K * 2;
    const size_t hsB0 = bhstep<PAT0>(K), hsB1 = bhstep<PAT1>(K);
    const unsigned ldsw = (unsigned)wid * 1024u;
    const int aoff = lds_byte(wr * 64 + fr, fq * 8), boff = lds_byte(wc * 32 + fr, fq * 8);
#define PG8_SA(b, h) (((b) * 2 + (h)) * HTB)
#define PG8_SB(b, h) ((4 + (b) * 2 + (h)) * HTB)
#define PG8_STAGE(bufoff, gbase, v0, v1) do { \
        __builtin_amdgcn_global_load_lds((const unsigned*)((const char*)(gbase) + (v0)), (LAS unsigned*)(lds + (bufoff) + ldsw), 16, 0, 0); \
        __builtin_amdgcn_global_load_lds((const unsigned*)((const char*)(gbase) + (v1)), (LAS unsigned*)(lds + (bufoff) + ldsw + 8192), 16, 0, 0); } while (0)
#define PG8_LDA(dst, b, h) do { _Pragma("unroll") for (int m = 0; m < 4; ++m) _Pragma("unroll") for (int k = 0; k < 2; ++k) dst[m][k] = *(const LAS bf16x8*)(lds + PG8_SA(b, h) + aoff + m * 2048 + k * 1024); } while (0)
#define PG8_LDB(dst, b, h) do { _Pragma("unroll") for (int n = 0; n < 2; ++n) _Pragma("unroll") for (int k = 0; k < 2; ++k) dst[n][k] = *(const LAS bf16x8*)(lds + PG8_SB(b, h) + boff + n * 2048 + k * 1024); } while (0)
#define PG8_MMA(ai, bj, At, Bt) do { __builtin_amdgcn_s_setprio(1); _Pragma("unroll") for (int m = 0; m < 4; ++m) _Pragma("unroll") for (int n = 0; n < 2; ++n) _Pragma("unroll") for (int k = 0; k < 2; ++k) \
        acc[ai][bj][m][n] = __builtin_amdgcn_mfma_f32_16x16x32_bf16(Bt[n][k], At[m][k], acc[ai][bj][m][n], 0, 0, 0); __builtin_amdgcn_s_setprio(0); } while (0)
#define PG8_WAIT_V(n) asm volatile("s_waitcnt vmcnt(" #n ")" ::: "memory")
#define PG8_WAIT_L(n) asm volatile("s_waitcnt lgkmcnt(" #n ")" ::: "memory")
#define PG8_BAR __builtin_amdgcn_s_barrier()
#define PG8_SCHED __builtin_amdgcn_sched_barrier(0)
    Unit cur, nxt; int ui = 0;
    if (!S.next(0, cur)) return;
    f32x4 acc[2][2][4][2];
#pragma unroll
    for (int a = 0; a < 2; ++a)
#pragma unroll
        for (int b = 0; b < 2; ++b)
#pragma unroll
            for (int m = 0; m < 4; ++m)
#pragma unroll
                for (int n = 0; n < 2; ++n) acc[a][b][m][n] = (f32x4){0.f, 0.f, 0.f, 0.f};
    bf16x8 At[4][2], B0[2][2], B1[2][2];
    const char* cA = cur.a; const char* cB = cur.b;
    unsigned cv0 = (cur.flags & 1) ? voffB1[0] : voffB0[0], cv1 = (cur.flags & 1) ? voffB1[1] : voffB0[1];
    size_t chb = (cur.flags & 1) ? hsB1 : hsB0;
    PG8_STAGE(PG8_SB(0, 0), cB, cv0, cv1); PG8_STAGE(PG8_SA(0, 0), cA, voffA[0], voffA[1]); PG8_STAGE(PG8_SB(0, 1), cB + chb, cv0, cv1); PG8_STAGE(PG8_SA(0, 1), cA + hstepA, voffA[0], voffA[1]);
    if (wr == 1) PG8_BAR;
    PG8_WAIT_V(4); PG8_BAR;
    PG8_STAGE(PG8_SB(1, 0), cB + kstep, cv0, cv1); PG8_STAGE(PG8_SA(1, 0), cA + kstep, voffA[0], voffA[1]); PG8_STAGE(PG8_SB(1, 1), cB + chb + kstep, cv0, cv1);
    PG8_WAIT_V(6); PG8_BAR;
    for (;;) {
        const bool has_next = S.next(ui + 1, nxt);
        const char* nA = has_next ? nxt.a : cA; const char* nB = has_next ? nxt.b : cB;
        const unsigned nv0 = has_next ? ((nxt.flags & 1) ? voffB1[0] : voffB0[0]) : cv0, nv1 = has_next ? ((nxt.flags & 1) ? voffB1[1] : voffB0[1]) : cv1;
        const size_t nhb = has_next ? ((nxt.flags & 1) ? hsB1 : hsB0) : chb;
        for (int t = 0; t < nt; t += 2) {
            const bool last = (t == nt - 2);
            const char* a1 = cA + (size_t)(t + 1) * kstep;
            const char* a2 = last ? nA : cA + (size_t)(t + 2) * kstep; const char* b2 = last ? nB : cB + (size_t)(t + 2) * kstep;
            const unsigned w0 = last ? nv0 : cv0, w1 = last ? nv1 : cv1; const size_t hb2 = last ? nhb : chb;
            const char* a3 = a2 + kstep; const char* b3 = b2 + kstep;
            PG8_LDB(B0, 0, 0); PG8_SCHED; PG8_LDA(At, 0, 0); PG8_STAGE(PG8_SA(1, 1), a1 + hstepA, voffA[0], voffA[1]);
            PG8_WAIT_L(8); PG8_BAR; PG8_WAIT_L(0); PG8_MMA(0, 0, At, B0); PG8_BAR; PG8_SCHED;
            PG8_LDB(B1, 0, 1); PG8_STAGE(PG8_SB(0, 0), b2, w0, w1);
            PG8_BAR; PG8_WAIT_L(0); PG8_MMA(0, 1, At, B1); PG8_BAR;
            PG8_LDA(At, 0, 1); PG8_STAGE(PG8_SA(0, 0), a2, voffA[0], voffA[1]);
            PG8_BAR; PG8_WAIT_L(0); PG8_MMA(1, 0, At, B0); PG8_BAR; PG8_SCHED;
            PG8_STAGE(PG8_SB(0, 1), b2 + hb2, w0, w1);
            PG8_WAIT_V(6); PG8_BAR; PG8_MMA(1, 1, At, B1); PG8_BAR;
            PG8_LDB(B0, 1, 0); PG8_SCHED; PG8_LDA(At, 1, 0); PG8_STAGE(PG8_SA(0, 1), a2 + hstepA, voffA[0], voffA[1]);
            PG8_WAIT_L(8); PG8_BAR; PG8_WAIT_L(0); PG8_MMA(0, 0, At, B0); PG8_BAR; PG8_SCHED;
            PG8_LDB(B1, 1, 1); PG8_STAGE(PG8_SB(1, 0), b3, w0, w1);
            PG8_BAR; PG8_WAIT_L(0); PG8_MMA(0, 1, At, B1); PG8_BAR;
            PG8_LDA(At, 1, 1); PG8_STAGE(PG8_SA(1, 0), a3, voffA[0], voffA[1]);
            PG8_BAR; PG8_WAIT_L(0); PG8_MMA(1, 0, At, B0); PG8_BAR; PG8_SCHED;
            PG8_STAGE(PG8_SB(1, 1), b3 + hb2, w0, w1);
            PG8_WAIT_V(6); PG8_BAR; PG8_MMA(1, 1, At, B1); PG8_BAR;
        }
        E(acc, cur, wr, wc, fr, fq);
        if (!has_next) break;
#pragma unroll
        for (int a = 0; a < 2; ++a)
#pragma unroll
            for (int b = 0; b < 2; ++b)
#pragma unroll
                for (int m = 0; m < 4; ++m)
#pragma unroll
                    for (int n = 0; n < 2; ++n) acc[a][b][m][n] = (f32x4){0.f, 0.f, 0.f, 0.f};
        cur = nxt; cA = nA; cB = nB; cv0 = nv0; cv1 = nv1; chb = nhb; ++ui;
    }
    PG8_WAIT_V(0);
    if (wr == 0) PG8_BAR;
    PG8_BAR;
#undef PG8_SA
#undef PG8_SB
#undef PG8_STAGE
#undef PG8_LDA
#undef PG8_LDB
#undef PG8_MMA
#undef PG8_WAIT_V
#undef PG8_WAIT_L
#undef PG8_BAR
#undef PG8_SCHED
}

struct EpiBf16 {
    __device__ __forceinline__ void operator()(const f32x4 (&acc)[2][2][4][2], const Unit& u, int wr, int wc, int fr, int fq) const {
        bf16_t* base = (bf16_t*)u.o + (size_t)(wr * 64 + fr) * u.ldc + wc * 32 + 8 * fq;
        const bool act = (u.flags & 16) != 0;
#pragma unroll
        for (int ai = 0; ai < 2; ++ai)
#pragma unroll
            for (int m = 0; m < 4; ++m) { bf16_t* rowp = base + (size_t)(ai * HALF + m * 16) * u.ldc;
#pragma unroll
                for (int bj = 0; bj < 2; ++bj) { f32x4 v0 = acc[ai][bj][m][0], v1 = acc[ai][bj][m][1];
                    if (act) {
#pragma unroll
                        for (int j = 0; j < 4; ++j) { v0[j] = fsilu(v0[j]); v1[j] = fsilu(v1[j]); } }
                    u32x4 w; w.x = pk2(v0[0], v0[1]); w.y = pk2(v0[2], v0[3]); w.z = pk2(v1[0], v1[1]); w.w = pk2(v1[2], v1[3]);
                    *(u32x4*)(rowp + bj * HALF) = w; } }
    }
};
struct EpiOutF32 {
    const float* x; float* out; const float* mod;
    __device__ __forceinline__ void operator()(const f32x4 (&acc)[2][2][4][2], const Unit& u, int wr, int wc, int fr, int fq) const {
        const int row0 = u.pm * BM + wr * 64 + fr, col0 = u.pn * BM + wc * 32 + 4 * fq;
        const int b = (u.pm * BM) / TT;
        f32x4 gv[2][2];
#pragma unroll
        for (int bj = 0; bj < 2; ++bj)
#pragma unroll
            for (int n = 0; n < 2; ++n) gv[bj][n] = *(const f32x4*)(mod + b * 3072 + 2048 + col0 + bj * HALF + n * 16);
#pragma unroll
        for (int ai = 0; ai < 2; ++ai)
#pragma unroll
            for (int m = 0; m < 4; ++m) { const size_t off = (size_t)(row0 + ai * HALF + m * 16) * DM + col0;
#pragma unroll
                for (int bj = 0; bj < 2; ++bj)
#pragma unroll
                    for (int n = 0; n < 2; ++n) { const f32x4 xv = *(const f32x4*)(x + off + bj * HALF + n * 16);
                        *(f32x4*)(out + off + bj * HALF + n * 16) = xv + gv[bj][n] * acc[ai][bj][m][n]; } }
    }
};
}

struct Args { const float* in[18]; float* out; unsigned char* ws; int ph_lo, ph_hi; };
struct Frame {
    LAS unsigned char* lds; volatile LAS unsigned* MISC; unsigned* ctl;
    int tid, lane, wave, G, bid, vcu;
    unsigned char* ws;
};
#define WSP(T, off) ((T*)(F.ws + (off)))

__device__ __forceinline__ void transpose_item(const float* W, int ldw, bf16_t* WT, int ldt, LAS float* scr, int kb, int nb, int lane) {
    const int k0 = 64 * kb, n0 = 32 * nb;
#pragma unroll 8
    for (int i = 0; i < 32; ++i) { const int kk = 2 * i + (lane >> 5); scr[kk * 33 + (lane & 31)] = W[(size_t)(k0 + kk) * ldw + n0 + (lane & 31)]; }
    LDS_WAIT(); asm volatile("" ::: "memory");
    const int c = lane & 7;
#pragma unroll
    for (int j = 0; j < 4; ++j) { const int n = (lane >> 3) + 8 * j; const LAS float* s = scr + (8 * c) * 33 + n;
        u32x4 o; o.x = pk2(s[0 * 33], s[1 * 33]); o.y = pk2(s[2 * 33], s[3 * 33]); o.z = pk2(s[4 * 33], s[5 * 33]); o.w = pk2(s[6 * 33], s[7 * 33]);
        *(u32x4*)(WT + (size_t)(n0 + n) * ldt + k0 + 8 * c) = o; }
    LDS_WAIT(); asm volatile("" ::: "memory");
}
struct SchedP1 {
    int G, c; unsigned char* ws;
    __device__ __forceinline__ bool next(int i, pg8::Unit& u) const {
        const int L = i * G + c;
        if (L < 256) {
            const int x = L & 7, j = L >> 3, pm = j & 3, pn = x * 8 + (j >> 2), b = pn >> 5, pnl = pn & 31;
            u.a = (const char*)(ws + WS_WFOLD) + (size_t)pm * 256 * DM * 2;
            u.b = (const char*)(ws + WS_HX) + ((size_t)b * TT + 4 * pnl) * DM * 2;
            u.o = (char*)(ws + WS_ZT) + ((size_t)pm * 256 * MLAT + (size_t)pn * 256) * 2;
            u.ldc = MLAT; u.flags = 1; u.pm = pm; u.pn = pn; return true;
        }
        const int Lr = L - 256; int pm, pn;
        if (Lr < 384) { const int x = Lr & 7, j = Lr >> 3; pm = 8 * x + (j & 7); pn = j >> 3; }
        else if (Lr < 388) { const int q = Lr - 384; pm = 64 + (q >> 1); pn = 2 + (q & 1); }
        else return false;
        const int seg = pn >> 1;
        u.a = (const char*)(ws + WS_HX) + (size_t)pm * 256 * DM * 2;
        u.b = (const char*)(ws + WS_WREST) + (size_t)pn * 256 * DM * 2;
        unsigned char* ob = ws + (seg == 0 ? WS_GF : (seg == 1 ? WS_UL : WS_GL));
        u.o = (char*)ob + ((size_t)pm * 256 * 512 + (size_t)(pn & 1) * 256) * 2;
        u.ldc = 512; u.flags = (seg != 1) ? 16 : 0; u.pm = pm; u.pn = pn; return true;
    }
};
struct SchedP4 {
    int G, c; unsigned char* ws;
    __device__ __forceinline__ bool next(int i, pg8::Unit& u) const {
        const int L = i * G + c; if (L >= 256) return false;
        const int x = L & 7, j = L >> 3, pm = 8 * x + (j & 7), pn = j >> 3;
        u.a = (const char*)(ws + WS_Y) + (size_t)pm * 256 * DM * 2;
        u.b = (const char*)(ws + WS_WOUT) + (size_t)pn * 256 * DM * 2;
        u.o = nullptr; u.ldc = DM; u.flags = 0; u.pm = pm; u.pn = pn; return true;
    }
};

__device__ __forceinline__ float wave_sum(float v) {
#pragma unroll
    for (int o = 1; o < 64; o <<= 1) v += __shfl_xor(v, o);
    return v;
}
struct SchedFold {
    int G, c; unsigned char* ws;
    __device__ __forceinline__ bool next(int i, pg8::Unit& u) const {
        const int L = i * G + c; if (L >= 16) return false;
        const int pm = L >> 2, pn = L & 3;
        u.a = (const char*)(ws + WS_MT) + (size_t)pm * 256 * 512 * 2;
        u.b = (const char*)(ws + WS_WINF) + (size_t)pn * 256 * 512 * 2;
        u.o = (char*)(ws + WS_WFOLD) + ((size_t)pm * 256 * DM + (size_t)pn * 256) * 2;
        u.ldc = DM; u.flags = 0; u.pm = pm; u.pn = pn; return true;
    }
};

__device__ __forceinline__ void p0_prep(Frame& F, const Args& args) {
    LAS float* scr = (LAS float*)(F.lds + F.wave * 16384);
    const int gw = F.wave * F.G + F.bid, NGW = F.G * NWAVES, lane = F.lane;
    const float* w_in = args.in[7]; const float* w_out = args.in[16]; const float* w_rg = args.in[11]; const float* w_ig = args.in[13];
    const float* w4 = args.in[8]; const float* w_ada = args.in[4];
    constexpr int I_MT = 512, I_MOD = 384, I_REST = 16 * 48, I_OUT = 16 * 32, I_G = 16 * 8, I_WINF = 1024;
    for (int it = gw; it < I_MT + I_MOD + I_REST + I_OUT + I_G + I_WINF; it += NGW) {
        int r = it;
        if (r < I_MT) {
            const int g = r >> 7, ob = (r >> 4) & 7, cb = r & 15, o = 64 * ob + lane, c0 = 8 * cb;
            float aC[8], aS[8];
#pragma unroll
            for (int cc = 0; cc < 8; ++cc) { aC[cc] = 0.f; aS[cc] = 0.f; }
            const float* wp = w4 + (size_t)(g * 128) * 512 + o;
#pragma unroll 4
            for (int m = 0; m < 128; ++m) {
                const float wv = wp[(size_t)m * 512];
#pragma unroll
                for (int cc = 0; cc < 8; ++cc) { const float2 t = CS128C[(m * (c0 + cc)) & 127]; aC[cc] += wv * t.x; aS[cc] += wv * t.y; }
            }
            const float sc = 1.0f / 1024.0f;
            u32x4 oc, os;
            oc.x = pk2(aC[0] * sc, aC[1] * sc); oc.y = pk2(aC[2] * sc, aC[3] * sc); oc.z = pk2(aC[4] * sc, aC[5] * sc); oc.w = pk2(aC[6] * sc, aC[7] * sc);
            os.x = pk2(-aS[0] * sc, -aS[1] * sc); os.y = pk2(-aS[2] * sc, -aS[3] * sc); os.z = pk2(-aS[4] * sc, -aS[5] * sc); os.w = pk2(-aS[6] * sc, -aS[7] * sc);
            bf16_t* mt = WSP(bf16_t, WS_MT);
            *(u32x4*)(mt + (size_t)o * 512 + g * 128 + c0) = oc;
            *(u32x4*)(mt + (size_t)(512 + o) * 512 + g * 128 + c0) = os;
            continue;
        } r -= I_MT;
        if (r < I_MOD) {
            const int nb = r >> 3, kb = r & 7, n = 64 * nb + lane;
            float sv[3][2];
#pragma unroll
            for (int rr = 0; rr < 3; ++rr) { const float* cv = rr < 2 ? args.in[1] + rr * DM : args.in[3];
#pragma unroll
                for (int q = 0; q < 2; ++q) { const float v = cv[128 * kb + 64 * q + lane]; sv[rr][q] = v / (1.0f + __expf(-v)); } }
            float acc[3] = {0.f, 0.f, 0.f};
            const float* wp = w_ada + (size_t)(128 * kb) * 3072 + n;
#pragma unroll
            for (int kk = 0; kk < 128; ++kk) {
                const float wv = wp[(size_t)kk * 3072];
#pragma unroll
                for (int rr = 0; rr < 3; ++rr) acc[rr] += wv * __uint_as_float(__builtin_amdgcn_readlane(__float_as_uint(sv[rr][kk >> 6]), kk & 63));
            }
            float* mp = WSP(float, WS_MODP) + (size_t)kb * 3 * 3072 + n;
#pragma unroll
            for (int rr = 0; rr < 3; ++rr) mp[rr * 3072] = acc[rr];
            continue;
        } r -= I_MOD;
        if (r < I_REST) { transpose_item(w_in + 512, 2048, WSP(bf16_t, WS_WREST), DM, scr, r / 48, r % 48, lane); continue; } r -= I_REST;
        if (r < I_OUT) { transpose_item(w_out, DM, WSP(bf16_t, WS_WOUT), DM, scr, r / 32, r % 32, lane); continue; } r -= I_OUT;
        if (r < I_G) { const int mi = r >> 3, q = r & 7, dir = mi >> 3, gate = (mi >> 2) & 1, h = mi & 3;
          const float* src = (gate ? w_ig : w_rg) + ((size_t)dir * 4 + h) * 16384;
          transpose_item(src, 128, WSP(bf16_t, WS_WG) + (size_t)mi * 16384, 128, scr, q >> 2, q & 3, lane); continue; } r -= I_G;
        {
            const f32x4* src = (const f32x4*)(w_in + (size_t)r * 2048) + 2 * lane; const f32x4 v0 = src[0], v1 = src[1];
            u32x4 o; o.x = pk2(v0[0], v0[1]); o.y = pk2(v0[2], v0[3]); o.z = pk2(v1[0], v1[1]); o.w = pk2(v1[2], v1[3]);
            *(u32x4*)(WSP(bf16_t, WS_WINF) + (size_t)r * 512 + 8 * lane) = o;
        }
    }
}

constexpr int CW_HXROW = 64;
__device__ __forceinline__ void p0b_fold_hx(Frame& F, const Args& args) {
    if (F.bid < 16) { SchedFold S{F.G, F.bid, F.ws}; pg8::EpiBf16 E; pg8::gemm_phase<pg8::PAT_PERM, pg8::PAT_PERM>(F.lds, 512, S, E); }
    __syncthreads();
    LAS float* Sv = (LAS float*)F.lds; LAS float* Sh = Sv + 3072;
    const float* modp = WSP(const float, WS_MODP); const float* b_ada = args.in[5]; const float* g = args.in[6];
    for (int i = F.tid; i < 3 * 3072; i += NWAVES * 64) {
        const int rr = i / 3072, n = i % 3072; float v = b_ada[n];
#pragma unroll
        for (int kb = 0; kb < 8; ++kb) v += modp[(size_t)kb * 9216 + i];
        if (n < 1024) Sh[rr * 1024 + n] = v; else if (n < 2048) Sv[rr * 1024 + (n - 1024)] = g[n - 1024] * (1.0f + v);
        if (F.bid == 0) WSP(float, WS_MOD)[i] = v;
    }
    __syncthreads();
    const float* x = args.in[0]; const float* ctx = args.in[2]; bf16_t* hx = WSP(bf16_t, WS_HX);
    {
        const int nfold = F.G > 32 ? 16 : 0;
        if (F.bid >= nfold) {
            const int gw = (F.bid - nfold) + F.wave * (F.G - nfold), NGW = (F.G - nfold) * NWAVES;
            for (int row = gw; row < MTOT; row += NGW) {
                const float* xr; int mr;
                if (row < MLAT) { xr = x + (size_t)row * DM; mr = row / TT; } else { xr = ctx + (size_t)(row - MLAT) * DM; mr = 2; }
                const f32x4* xp = (const f32x4*)xr + F.lane; f32x4 v[4]; float s = 0.f;
#pragma unroll
                for (int j = 0; j < 4; ++j) { v[j] = xp[64 * j]; s += (v[j][0] * v[j][0] + v[j][1] * v[j][1]) + (v[j][2] * v[j][2] + v[j][3] * v[j][3]); }
                const float rstd = rsqrtf(wave_sum(s) * (1.0f / DM) + 1e-6f);
                u32x2* o8 = (u32x2*)(hx + (size_t)row * DM) + F.lane;
#pragma unroll
                for (int j = 0; j < 4; ++j) { const f32x4 sc = *(const LAS f32x4*)(Sv + mr * 1024 + 256 * j + 4 * F.lane), sh = *(const LAS f32x4*)(Sh + mr * 1024 + 256 * j + 4 * F.lane);
                    const f32x4 h = v[j] * rstd * sc + sh; u32x2 w; w.x = pk2(h[0], h[1]); w.y = pk2(h[2], h[3]); o8[64 * j] = w; }
            }
        }
    }
}

__device__ __forceinline__ void p5_final(Frame& F, const Args& args) {
    const int gw = F.vcu * NWAVES + F.wave, NGW = F.G * NWAVES; const float* fg = args.in[17];
    f32x4 gv[4];
#pragma unroll
    for (int j = 0; j < 4; ++j) gv[j] = ((const f32x4*)fg)[64 * j + F.lane];
    for (int row = gw; row < MLAT; row += NGW) {
        f32x4* xp = (f32x4*)(args.out + (size_t)row * DM) + F.lane; f32x4 v[4]; float s = 0.f;
#pragma unroll
        for (int j = 0; j < 4; ++j) { v[j] = xp[64 * j]; s += (v[j][0] * v[j][0] + v[j][1] * v[j][1]) + (v[j][2] * v[j][2] + v[j][3] * v[j][3]); }
        const float rstd = rsqrtf(wave_sum(s) * (1.0f / DM) + 1e-6f);
#pragma unroll
        for (int j = 0; j < 4; ++j) xp[64 * j] = v[j] * rstd * gv[j];
    }
}

constexpr int FFT_F1_OFF = 0, FFT_TW_OFF = 65536;
__device__ __forceinline__ int crow(int reg, int h) { return (reg & 3) + 8 * (reg >> 2) + 4 * h; }
#define MFMA32(a, b, c) __builtin_amdgcn_mfma_f32_32x32x16_bf16((a), (b), (c), 0, 0, 0)
__device__ __forceinline__ bf16x8 neg8(bf16x8 v) { u32x4 u = __builtin_bit_cast(u32x4, v); u ^= 0x80008000u; return __builtin_bit_cast(bf16x8, u); }

__device__ __forceinline__ void fft_tables(Frame& F) {
    LAS f32x2* cs128 = (LAS f32x2*)(F.lds + MISC_CS128_OFF);
    for (int e = F.tid; e < 64 * 64; e += NWAVES * 64) {
        const int f = e >> 6, lane = e & 63, r = lane & 31, hh = lane >> 5, plane = f & 1, s = (f >> 1) & 1, j = (f >> 2) & 3, mt = f >> 4;
        const int k1 = 32 * mt + r; float v[8];
#pragma unroll
        for (int jj = 0; jj < 8; ++jj) { const int n1 = 32 * j + 16 * s + 8 * (jj >> 2) + 4 * hh + (jj & 3); const f32x2 t = cs128[(k1 * n1) & 127]; v[jj] = plane ? t.y : t.x; }
        u32x4 o; o.x = pk2(v[0], v[1]); o.y = pk2(v[2], v[3]); o.z = pk2(v[4], v[5]); o.w = pk2(v[6], v[7]);
        *(LAS u32x4*)(F.lds + FFT_F1_OFF + e * 16) = o;
    }
    for (int e = F.tid; e < 64 * 64; e += NWAVES * 64) {
        const int lane = e & 63, q = (e >> 6) & 7, h = (e >> 9) & 1, j = e >> 10, r = lane & 31, hh = lane >> 5, k2 = 32 * h + r;
        f32x4 o;
        { const int n1 = 32 * j + crow(2 * q, hh); float sv, cv; sincospif((float)(n1 * k2) * (1.0f / 4096.0f), &sv, &cv); o[0] = cv; o[1] = sv; }
        { const int n1 = 32 * j + crow(2 * q + 1, hh); float sv, cv; sincospif((float)(n1 * k2) * (1.0f / 4096.0f), &sv, &cv); o[2] = cv; o[3] = sv; }
        *(LAS f32x4*)(F.lds + FFT_TW_OFF + e * 16) = o;
    }
}

__device__ __forceinline__ void fft_task(Frame& F, int bt) {
    LAS f32x2* cs128 = (LAS f32x2*)(F.lds + MISC_CS128_OFF);
    const int lane = F.lane, r = lane & 31, hh = lane >> 5, w = F.wave, h = w & 1;
    const int col = bt * 4 + (w >> 1), b = col >> 9, chan = col & 511;
    const bf16_t* zr = WSP(const bf16_t, WS_ZT) + (size_t)chan * MLAT + (size_t)b * TT;
    const bf16_t* zi = zr + (size_t)512 * MLAT;
    bf16x8 c2[4], s2[4];
#pragma unroll
    for (int s = 0; s < 4; ++s) { float cv[8], sv[8];
#pragma unroll
        for (int jj = 0; jj < 8; ++jj) { const int n2 = 16 * s + 8 * hh + jj, k2 = 32 * h + r; const f32x2 t = cs128[(2 * n2 * k2) & 127]; cv[jj] = t.x; sv[jj] = t.y; }
        u32x4 oc, os; oc.x = pk2(cv[0], cv[1]); oc.y = pk2(cv[2], cv[3]); oc.z = pk2(cv[4], cv[5]); oc.w = pk2(cv[6], cv[7]);
        os.x = pk2(sv[0], sv[1]); os.y = pk2(sv[2], sv[3]); os.z = pk2(sv[4], sv[5]); os.w = pk2(sv[6], sv[7]);
        c2[s] = __builtin_bit_cast(bf16x8, oc); s2[s] = __builtin_bit_cast(bf16x8, os); }
    f32x16 X[4];
#pragma unroll
    for (int mt = 0; mt < 4; ++mt)
#pragma unroll
        for (int i = 0; i < 16; ++i) X[mt][i] = 0.f;
#pragma unroll 1
    for (int j = 0; j < 4; ++j) {
        f32x16 Tr, Ti;
#pragma unroll
        for (int i = 0; i < 16; ++i) { Tr[i] = 0.f; Ti[i] = 0.f; }
        const size_t rowoff = (size_t)(32 * j + r) * 64 + 8 * hh;
#pragma unroll
        for (int s = 0; s < 4; ++s) {
            const bf16x8 ar = *(const bf16x8*)(zr + rowoff + 16 * s), ai = *(const bf16x8*)(zi + rowoff + 16 * s);
            const bf16x8 arn = neg8(ar);
            Tr = MFMA32(ar, c2[s], Tr); Tr = MFMA32(ai, s2[s], Tr);
            Ti = MFMA32(ai, c2[s], Ti); Ti = MFMA32(arn, s2[s], Ti);
        }
        u32x4 pr[2], pi[2];
#pragma unroll
        for (int q = 0; q < 8; ++q) {
            const f32x4 tw = *(const LAS f32x4*)(F.lds + FFT_TW_OFF + ((((j * 2 + h) * 8 + q) * 64 + lane) * 16));
            const float tr0 = Tr[2 * q], ti0 = Ti[2 * q], tr1 = Tr[2 * q + 1], ti1 = Ti[2 * q + 1];
            const float r0 = tr0 * tw[0] + ti0 * tw[1], i0 = ti0 * tw[0] - tr0 * tw[1];
            const float r1 = tr1 * tw[2] + ti1 * tw[3], i1 = ti1 * tw[2] - tr1 * tw[3];
            pr[q >> 2][q & 3] = pk2(r0, r1); pi[q >> 2][q & 3] = pk2(i0, i1);
        }
#pragma unroll
        for (int mt = 0; mt < 4; ++mt)
#pragma unroll
            for (int s = 0; s < 2; ++s) {
                const bf16x8 fc = *(const LAS bf16x8*)(F.lds + FFT_F1_OFF + ((((mt * 4 + j) * 2 + s) * 2 + 0) * 64 + lane) * 16);
                const bf16x8 fs = *(const LAS bf16x8*)(F.lds + FFT_F1_OFF + ((((mt * 4 + j) * 2 + s) * 2 + 1) * 64 + lane) * 16);
                X[mt] = MFMA32(fc, __builtin_bit_cast(bf16x8, pr[s]), X[mt]);
                X[mt] = MFMA32(fs, __builtin_bit_cast(bf16x8, pi[s]), X[mt]);
            }
    }
    bf16_t* yo = WSP(bf16_t, WS_YFT) + ((size_t)b * 512 + chan) * TT + 32 * h + r;
#pragma unroll
    for (int mt = 0; mt < 4; ++mt)
#pragma unroll
        for (int i = 0; i < 16; ++i) { const int k1 = 32 * mt + crow(i, hh); yo[64 * k1] = f2bf(X[mt][i]); }
}
#define MFMA16(a, b, c) __builtin_amdgcn_mfma_f32_16x16x32_bf16((a), (b), (c), 0, 0, 0)
constexpr int LRU_V_OFF = 0, LRU_V_PITCH = 272;
constexpr int LRU_HB_OFF = 36864, LRU_HB_PITCH = 528;
constexpr int NCI = 66;
__device__ __forceinline__ size_t sum_idx(int b, int ci, int dir, int ch) { return ((((size_t)b * NCI + ci) * 2 + dir) * 512 + ch); }

__device__ __forceinline__ void lru_conv_to_lds(Frame& F, const Args& args, int b, int ci, int hd) {
    const bf16_t* ul = WSP(const bf16_t, WS_UL); const float* conv_w = args.in[9]; const float* conv_b = args.in[10];
    const int c8 = F.tid & 15, tg = F.tid >> 4, ch0 = hd * 128 + 8 * c8;
    int L, t0; size_t rbase;
    if (ci < 2) { L = CTXL; t0 = 128 * ci; rbase = (size_t)MLAT + (size_t)b * CTXL; } else { L = TT; t0 = 128 * (ci - 2); rbase = (size_t)b * TT; }
    float in[7][8];
#pragma unroll
    for (int q = 0; q < 7; ++q) { const int t = t0 + 4 * tg - 2 + q;
        if (t >= 0 && t < L) { const u32x4 v = *(const u32x4*)(ul + (rbase + t) * 512 + ch0);
#pragma unroll
            for (int i = 0; i < 4; ++i) { in[q][2 * i] = __uint_as_float(v[i] << 16); in[q][2 * i + 1] = __uint_as_float(v[i] & 0xffff0000u); } }
        else {
#pragma unroll
            for (int i = 0; i < 8; ++i) in[q][i] = 0.f; } }
    float cw[4][8], cb[8];
#pragma unroll
    for (int j = 0; j < 4; ++j) { const f32x4 a = *(const f32x4*)(conv_w + j * 512 + ch0), c = *(const f32x4*)(conv_w + j * 512 + ch0 + 4);
#pragma unroll
        for (int i = 0; i < 4; ++i) { cw[j][i] = a[i]; cw[j][4 + i] = c[i]; } }
    { const f32x4 a = *(const f32x4*)(conv_b + ch0), c = *(const f32x4*)(conv_b + ch0 + 4);
#pragma unroll
      for (int i = 0; i < 4; ++i) { cb[i] = a[i]; cb[4 + i] = c[i]; } }
#pragma unroll
    for (int q = 0; q < 4; ++q) { float v[8];
#pragma unroll
        for (int i = 0; i < 8; ++i) v[i] = cb[i] + cw[0][i] * in[q][i] + cw[1][i] * in[q + 1][i] + cw[2][i] * in[q + 2][i] + cw[3][i] * in[q + 3][i];
        u32x4 o; o.x = pk2(v[0], v[1]); o.y = pk2(v[2], v[3]); o.z = pk2(v[4], v[5]); o.w = pk2(v[6], v[7]);
        *(LAS u32x4*)(F.lds + LRU_V_OFF + (4 * tg + q) * LRU_V_PITCH + c8 * 16) = o; }
}

__device__ __forceinline__ void lru_tile_gates(Frame& F, int s, const bf16x8 (&Brg)[4], const bf16x8 (&Big)[4], float brg, float big, float c8v, float (&a)[4], float (&bx)[4]) {
    const int lane = F.lane, g = lane >> 4, e = lane & 15;
    f32x4 arg = {0.f, 0.f, 0.f, 0.f}, aig = {0.f, 0.f, 0.f, 0.f};
#pragma unroll
    for (int ks = 0; ks < 4; ++ks) {
        const bf16x8 av = *(const LAS bf16x8*)(F.lds + LRU_V_OFF + (16 * s + e) * LRU_V_PITCH + (32 * ks + 8 * g) * 2);
        arg = MFMA16(av, Brg[ks], arg); aig = MFMA16(av, Big[ks], aig);
    }
#pragma unroll
    for (int i = 0; i < 4; ++i) {
        const float vv = bf2f(*(const LAS bf16_t*)(F.lds + LRU_V_OFF + (16 * s + 4 * g + i) * LRU_V_PITCH + (16 * F.wave + e) * 2));
        const float rr = fsigm(arg[i] + brg), ii = fsigm(aig[i] + big);
        const float la = -c8v * rr, av = __expf(la), x2 = 2.0f * la;
        const float om = (x2 > -0.02f) ? (-x2 * (1.0f + x2 * (0.5f + x2 * (0.16666667f + x2 * 0.041666668f)))) : (1.0f - av * av);
        a[i] = av; bx[i] = sqrtf(om) * (ii * vv);
    }
}

template <int PASS>
__device__ __forceinline__ void lru_task(Frame& F, const Args& args, int task) {
    const int hd = task & 3, rest = task >> 2;
    int b, ci;
    if (PASS == 1) { b = rest / NCI; ci = rest % NCI; } else { b = rest >> 6; ci = 2 + (rest & 63); }
    const int lane = F.lane, g = lane >> 4, e = lane & 15, w = F.wave, ch = hd * 128 + 16 * w + e;
    __syncthreads();
    for (int r2 = 0; r2 < (PROBE_REP == 11 ? 2 : 1); ++r2) lru_conv_to_lds(F, args, b, ci, hd);
    const float* b_rg = args.in[12]; const float* b_ig = args.in[14]; const float* lam = args.in[15];
    float cinf = 0.f, cinb = 0.f;
    for (int r2 = 0; r2 < (PROBE_REP == 12 ? 2 : 1); ++r2) if (PASS == 2) {
        const float2* sum = WSP(const float2, WS_SUM);
        float hf = 0.f;
        for (int cj = 0; cj < ci; ++cj) { const float2 t = sum[sum_idx(b, cj, 0, ch)]; hf = t.x * hf + t.y; }
        float hb = 0.f;
        { const float2 t1 = sum[sum_idx(b, 1, 1, ch)]; hb = t1.x * hb + t1.y; const float2 t0 = sum[sum_idx(b, 0, 1, ch)]; hb = t0.x * hb + t0.y; }
        for (int cj = NCI - 1; cj > ci; --cj) { const float2 t = sum[sum_idx(b, cj, 1, ch)]; hb = t.x * hb + t.y; }
        cinf = hf; cinb = hb;
    }
    __syncthreads();
#pragma unroll 1
    for (int sw2 = 0; sw2 < (PROBE_REP == 13 ? 4 : 2); ++sw2) { const int sw = sw2 & 1;
        const int dir = 1 - sw;
        bf16x8 Brg[4], Big[4];
        { const bf16_t* wg = WSP(const bf16_t, WS_WG) + ((size_t)(dir * 2 + 0) * 4 + hd) * 16384 + (size_t)(16 * w + e) * 128 + 8 * g;
#pragma unroll
          for (int ks = 0; ks < 4; ++ks) { Brg[ks] = *(const bf16x8*)(wg + 32 * ks); Big[ks] = *(const bf16x8*)(wg + (size_t)4 * 16384 + 32 * ks); } }
        const float brg = b_rg[dir * 512 + ch], big = b_ig[dir * 512 + ch];
        const float lv = lam[dir * 512 + ch]; const float c8v = 8.0f * (fmaxf(-lv, 0.f) + log1pf(__expf(-fabsf(lv))));
        float hin = (PASS == 2) ? (dir ? cinb : cinf) : 0.f, aprod = 1.0f;
#pragma unroll 1
        for (int st = 0; st < 8; ++st) {
            const int s = dir ? 7 - st : st;
            float a[4], bx[4];
            lru_tile_gates(F, s, Brg, Big, brg, big, c8v, a, bx);
            float A4 = (a[0] * a[1]) * (a[2] * a[3]);
            float B4 = dir ? (((bx[3] * a[2] + bx[2]) * a[1] + bx[1]) * a[0] + bx[0]) : (((bx[0] * a[1] + bx[1]) * a[2] + bx[2]) * a[3] + bx[3]);
            float Ag[4], Bg[4];
#pragma unroll
            for (int gg = 0; gg < 4; ++gg) { Ag[gg] = __shfl(A4, 16 * gg + e); Bg[gg] = __shfl(B4, 16 * gg + e); }
            float P0 = hin, P1, P2, P3, P4;
            if (dir) { P1 = Ag[3] * P0 + Bg[3]; P2 = Ag[2] * P1 + Bg[2]; P3 = Ag[1] * P2 + Bg[1]; P4 = Ag[0] * P3 + Bg[0]; }
            else     { P1 = Ag[0] * P0 + Bg[0]; P2 = Ag[1] * P1 + Bg[1]; P3 = Ag[2] * P2 + Bg[2]; P4 = Ag[3] * P3 + Bg[3]; }
            if (PASS == 1) aprod *= (Ag[0] * Ag[1]) * (Ag[2] * Ag[3]);
            if (PASS == 2) {
                const int go = dir ? 3 - g : g;
                float hcur = go == 0 ? P0 : (go == 1 ? P1 : (go == 2 ? P2 : P3));
                LAS float* hbp = (LAS float*)(F.lds + LRU_HB_OFF + (16 * s + 4 * g) * LRU_HB_PITCH + (16 * w + e) * 4);
                if (dir) {
#pragma unroll
                    for (int i = 3; i >= 0; --i) { hcur = a[i] * hcur + bx[i]; hbp[i * (LRU_HB_PITCH / 4)] = hcur; }
                } else {
#pragma unroll
                    for (int i = 0; i < 4; ++i) { hcur = a[i] * hcur + bx[i]; hbp[i * (LRU_HB_PITCH / 4)] += hcur; }
                }
            }
            hin = P4;
        }
        if (PASS == 1 && g == 0) WSP(float2, WS_SUM)[sum_idx(b, ci, dir, ch)] = make_float2(aprod, hin);
    }
    if (PASS == 2) {
        __syncthreads();
        const int c8 = F.tid & 15, tg = F.tid >> 4; const size_t row0 = (size_t)b * TT + 128 * (ci - 2) + 4 * tg;
        const bf16_t* gl = WSP(const bf16_t, WS_GL); bf16_t* y = WSP(bf16_t, WS_Y);
#pragma unroll
        for (int q = 0; q < 4; ++q) {
            const LAS f32x4* hp = (const LAS f32x4*)(F.lds + LRU_HB_OFF + (4 * tg + q) * LRU_HB_PITCH + c8 * 32);
            const f32x4 h0 = hp[0], h1 = hp[1];
            const u32x4 gv = *(const u32x4*)(gl + (row0 + q) * 512 + hd * 128 + 8 * c8);
            u32x4 o;
            o.x = pk2(h0[0] * __uint_as_float(gv.x << 16), h0[1] * __uint_as_float(gv.x & 0xffff0000u));
            o.y = pk2(h0[2] * __uint_as_float(gv.y << 16), h0[3] * __uint_as_float(gv.y & 0xffff0000u));
            o.z = pk2(h1[0] * __uint_as_float(gv.z << 16), h1[1] * __uint_as_float(gv.z & 0xffff0000u));
            o.w = pk2(h1[2] * __uint_as_float(gv.w << 16), h1[3] * __uint_as_float(gv.w & 0xffff0000u));
            *(u32x4*)(y + (row0 + q) * DM + 512 + hd * 128 + 8 * c8) = o;
        }
    }
}

constexpr int FT_PITCH = 260;
__device__ __forceinline__ void fourier_gate_task(Frame& F, int task) {
    const int hd = task & 3, rest = task >> 2, b = rest >> 6, c = rest & 63;
    for (int r2 = 0; r2 < (PROBE_REP == 14 ? 2 : 1); ++r2) {
    __syncthreads();
    { const int chan = F.tid >> 2, seg = F.tid & 3;
      const bf16_t* src = WSP(const bf16_t, WS_YFT) + ((size_t)b * 512 + hd * 128 + chan) * TT + 128 * c + 32 * seg;
#pragma unroll
      for (int q = 0; q < 4; ++q) { const u32x4 v = *(const u32x4*)(src + 8 * q);
          LAS unsigned* dst = (LAS unsigned*)(F.lds + chan * FT_PITCH + (32 * seg + 8 * q) * 2);
          dst[0] = v.x; dst[1] = v.y; dst[2] = v.z; dst[3] = v.w; } }
    __syncthreads();
    { const int tok = F.tid & 127, cq = F.tid >> 7; const size_t row = (size_t)b * TT + 128 * c + tok;
      const bf16_t* gf = WSP(const bf16_t, WS_GF); bf16_t* y = WSP(bf16_t, WS_Y);
#pragma unroll
      for (int c8 = 0; c8 < 4; ++c8) { const int ch0 = 32 * cq + 8 * c8; float v[8];
#pragma unroll
          for (int i = 0; i < 8; ++i) v[i] = bf2f(*(const LAS bf16_t*)(F.lds + (ch0 + i) * FT_PITCH + tok * 2));
          const u32x4 gv = *(const u32x4*)(gf + row * 512 + hd * 128 + ch0);
          u32x4 o;
          o.x = pk2(v[0] * __uint_as_float(gv.x << 16), v[1] * __uint_as_float(gv.x & 0xffff0000u));
          o.y = pk2(v[2] * __uint_as_float(gv.y << 16), v[3] * __uint_as_float(gv.y & 0xffff0000u));
          o.z = pk2(v[4] * __uint_as_float(gv.z << 16), v[5] * __uint_as_float(gv.z & 0xffff0000u));
          o.w = pk2(v[6] * __uint_as_float(gv.w << 16), v[7] * __uint_as_float(gv.w & 0xffff0000u));
          *(u32x4*)(y + row * DM + hd * 128 + ch0) = o; } }
    }
}
__global__ void __launch_bounds__(NWAVES * 64, 2) mk_fwd(Args args) {
    extern __shared__ __attribute__((aligned(16))) unsigned char lds_raw[];
    Frame F;
    F.lds = (LAS unsigned char*)lds_raw;
    F.MISC = (volatile LAS unsigned*)(F.lds + MISC_OFF);
    F.tid = threadIdx.x; F.lane = F.tid & 63; F.wave = __builtin_amdgcn_readfirstlane(F.tid >> 6);
    F.G = gridDim.x; F.bid = blockIdx.x; F.vcu = (F.G % 8 == 0) ? (F.bid % 8) * (F.G / 8) + F.bid / 8 : F.bid;
    F.ws = args.ws; F.ctl = (unsigned*)(args.ws + WS_CTL);
    if (F.tid < 32) F.MISC[F.tid] = 0u;
    if (F.tid >= 64 && F.tid < 192) { const int i = F.tid - 64; float sv, cv; sincospif((float)i * (1.0f / 64.0f), &sv, &cv); ((LAS f32x2*)(F.lds + MISC_CS128_OFF))[i] = (f32x2){cv, sv}; }
    __syncthreads();
    const int lo = args.ph_lo, hi = args.ph_hi;
    XcdBarrier bar; bar.bar = F.ctl + 1024; bar.x = 0; bar.st = nullptr;
    if (hi - lo > 1) bar = xcd_barrier_post(F.ctl + 1024, F.MISC + 8);
#ifndef PROBE_REP
#define PROBE_REP -1
#endif
#define REPS(k) ((PROBE_REP == (k)) ? 2 : 1)
#define RB(k) do { if (rep + 1 < REPS(k)) xcd_barrier(bar); } while (0)
#define IN(k) (lo <= (k) && (k) < hi)
#define SEAM(k) do { if (IN(k) && IN((k) + 1)) xcd_barrier(bar); } while (0)

    if (IN(0)) for (int rep = 0; rep < REPS(0); ++rep) { p0_prep(F, args); RB(0); }
    SEAM(0);
    if (IN(1)) for (int rep = 0; rep < REPS(1); ++rep) { p0b_fold_hx(F, args); RB(1); }
    SEAM(1);
    if (IN(2)) for (int rep = 0; rep < REPS(2); ++rep) {
        SchedP1 S{F.G, F.bid, F.ws}; pg8::EpiBf16 E;
        pg8::gemm_phase<pg8::PAT_PERM, pg8::PAT_FFT>(F.lds, DM, S, E); RB(2);
    }
    SEAM(2);
    if (IN(3)) for (int rep = 0; rep < REPS(3); ++rep) {
        __syncthreads(); fft_tables(F); __syncthreads();
        for (int r2 = 0; r2 < (PROBE_REP == 10 ? 2 : 1); ++r2) for (int bt = F.bid; bt < 256; bt += F.G) fft_task(F, bt);
        for (int task = F.bid; task < 528; task += F.G) lru_task<1>(F, args, task);
        RB(3);
    }
    SEAM(3);
    if (IN(4)) for (int rep = 0; rep < REPS(4); ++rep) { for (int task = F.bid; task < 512; task += F.G) { fourier_gate_task(F, task); lru_task<2>(F, args, task); } RB(4); }
    SEAM(4);
    if (IN(5)) for (int rep = 0; rep < REPS(5); ++rep) {
        SchedP4 S{F.G, F.bid, F.ws}; pg8::EpiOutF32 E{args.in[0], args.out, WSP(const float, WS_MOD)};
        pg8::gemm_phase<pg8::PAT_NAT, pg8::PAT_NAT>(F.lds, DM, S, E); RB(5);
    }
    SEAM(5);
    if (IN(6)) { p5_final(F, args); }
#undef IN
#undef SEAM
}

static int g_grid = 0;
static void mk_launch(const Args& base, int lo, int hi, hipStream_t stream) {
    Args a = base; a.ph_lo = lo; a.ph_hi = hi;
    hipLaunchKernelGGL(mk_fwd, dim3(g_grid), dim3(NWAVES * 64), LDS_BYTES, stream, a);
}
extern "C" void kernel_launch(void* const* d_in, const int* in_sizes, int n_in, void* d_out, int out_size, void* d_ws, size_t ws_size, hipStream_t stream) {
    if (g_grid == 0) {
        int dev = 0, cus = 0, per_cu = 0;
        (void)hipGetDevice(&dev); (void)hipDeviceGetAttribute(&cus, hipDeviceAttributeMultiprocessorCount, dev);
        (void)hipFuncSetAttribute((const void*)mk_fwd, hipFuncAttributeMaxDynamicSharedMemorySize, LDS_BYTES);
        (void)hipOccupancyMaxActiveBlocksPerMultiprocessor(&per_cu, (const void*)mk_fwd, NWAVES * 64, LDS_BYTES);
        (void)hipGetLastError();
        g_grid = cus > 0 ? cus : 256;
    }
    (void)hipMemsetAsync((char*)d_ws + WS_CTL, 0, CTL_ZERO_BYTES, stream);
    Args a{}; for (int i = 0; i < 18; ++i) a.in[i] = (const float*)d_in[i]; a.out = (float*)d_out; a.ws = (unsigned char*)d_ws;
    mk_launch(a, 0, 7, stream);
}
```

```cpp
#include <hip/hip_runtime.h>
#include <stdint.h>

typedef unsigned short bf16_t;

#define NB 2
#define TT 8192
#define DM 1024
#define CTXL 256
#define MLAT (NB * TT)
#define MCTX (NB * CTXL)
#define MTOT (MLAT + MCTX)
#define DF 512
#define DL 512
#define HD 128

__device__ __forceinline__ float bf2f(bf16_t b) { return __uint_as_float(((unsigned)b) << 16); }
__device__ __forceinline__ bf16_t f2bf(float f) { unsigned u = __float_as_uint(f); u += 0x7fffu + ((u >> 16) & 1u); return (bf16_t)(u >> 16); }
__device__ __forceinline__ float siluf(float v) { return v / (1.0f + expf(-v)); }
__device__ __forceinline__ float sigmf(float v) { return 1.0f / (1.0f + expf(-v)); }

constexpr size_t MiB = 1u << 20;
constexpr size_t WS_CTL = 0, CTL_ZERO_BYTES = 256 * 1024;
constexpr size_t WS_MODP = 512 * 1024;
constexpr size_t WS_MOD = 1 * MiB;
constexpr size_t WS_SUM = 1 * MiB + 64 * 1024;
constexpr size_t WS_WREST = 3 * MiB;
constexpr size_t WS_WFOLD = 6 * MiB;
constexpr size_t WS_WOUT = 8 * MiB;
constexpr size_t WS_WG = 10 * MiB;
constexpr size_t WS_MT = 11 * MiB;
constexpr size_t WS_WINF = 13 * MiB;
constexpr size_t WS_HX = 16 * MiB;
constexpr size_t WS_ZT = 50 * MiB;
constexpr size_t WS_GF = 82 * MiB;
constexpr size_t WS_UL = 98 * MiB;
constexpr size_t WS_GL = 115 * MiB;
constexpr size_t WS_YFT = 131 * MiB;
constexpr size_t WS_Y = 147 * MiB;
constexpr size_t WS_HF = 179 * MiB;
constexpr size_t WS_HB = 211 * MiB;

#ifndef PROBE_REP
#define PROBE_REP -1
#endif
#define LAS __attribute__((address_space(3)))
typedef short bf16x8 __attribute__((ext_vector_type(8)));
typedef float f32x4 __attribute__((ext_vector_type(4)));
typedef float f32x2 __attribute__((ext_vector_type(2)));
typedef float f32x16 __attribute__((ext_vector_type(16)));
typedef unsigned u32x4 __attribute__((ext_vector_type(4)));
typedef unsigned u32x2 __attribute__((ext_vector_type(2)));
typedef __bf16 bf16x2_t __attribute__((ext_vector_type(2)));
#define LDS_WAIT() asm volatile("s_waitcnt lgkmcnt(0)" ::: "memory")
#define VM_WAIT() asm volatile("s_waitcnt vmcnt(0)" ::: "memory")

__device__ __forceinline__ unsigned pk2(float a, float b) { f32x2 v = {a, b}; bf16x2_t r = __builtin_convertvector(v, bf16x2_t); return __builtin_bit_cast(unsigned, r); }
__device__ __forceinline__ float fsilu(float v) { return v * __builtin_amdgcn_rcpf(1.0f + __expf(-v)); }
__device__ __forceinline__ float fsigm(float v) { return __builtin_amdgcn_rcpf(1.0f + __expf(-v)); }

__constant__ float2 CS128C[128] = {{1.000000000e+00f, 0.000000000e+00f}, {9.987954562e-01f, 4.906767433e-02f}, {9.951847267e-01f, 9.801714033e-02f}, {9.891765100e-01f, 1.467304745e-01f}, {9.807852804e-01f, 1.950903220e-01f}, {9.700312532e-01f, 2.429801799e-01f}, {9.569403357e-01f, 2.902846773e-01f}, {9.415440652e-01f, 3.368898534e-01f}, {9.238795325e-01f, 3.826834324e-01f}, {9.039892931e-01f, 4.275550934e-01f}, {8.819212643e-01f, 4.713967368e-01f}, {8.577286100e-01f, 5.141027442e-01f}, {8.314696123e-01f, 5.555702330e-01f}, {8.032075315e-01f, 5.956993045e-01f}, {7.730104534e-01f, 6.343932842e-01f}, {7.409511254e-01f, 6.715589548e-01f}, {7.071067812e-01f, 7.071067812e-01f}, {6.715589548e-01f, 7.409511254e-01f}, {6.343932842e-01f, 7.730104534e-01f}, {5.956993045e-01f, 8.032075315e-01f}, {5.555702330e-01f, 8.314696123e-01f}, {5.141027442e-01f, 8.577286100e-01f}, {4.713967368e-01f, 8.819212643e-01f}, {4.275550934e-01f, 9.039892931e-01f}, {3.826834324e-01f, 9.238795325e-01f}, {3.368898534e-01f, 9.415440652e-01f}, {2.902846773e-01f, 9.569403357e-01f}, {2.429801799e-01f, 9.700312532e-01f}, {1.950903220e-01f, 9.807852804e-01f}, {1.467304745e-01f, 9.891765100e-01f}, {9.801714033e-02f, 9.951847267e-01f}, {4.906767433e-02f, 9.987954562e-01f}, {6.123233996e-17f, 1.000000000e+00f}, {-4.906767433e-02f, 9.987954562e-01f}, {-9.801714033e-02f, 9.951847267e-01f}, {-1.467304745e-01f, 9.891765100e-01f}, {-1.950903220e-01f, 9.807852804e-01f}, {-2.429801799e-01f, 9.700312532e-01f}, {-2.902846773e-01f, 9.569403357e-01f}, {-3.368898534e-01f, 9.415440652e-01f}, {-3.826834324e-01f, 9.238795325e-01f}, {-4.275550934e-01f, 9.039892931e-01f}, {-4.713967368e-01f, 8.819212643e-01f}, {-5.141027442e-01f, 8.577286100e-01f}, {-5.555702330e-01f, 8.314696123e-01f}, {-5.956993045e-01f, 8.032075315e-01f}, {-6.343932842e-01f, 7.730104534e-01f}, {-6.715589548e-01f, 7.409511254e-01f}, {-7.071067812e-01f, 7.071067812e-01f}, {-7.409511254e-01f, 6.715589548e-01f}, {-7.730104534e-01f, 6.343932842e-01f}, {-8.032075315e-01f, 5.956993045e-01f}, {-8.314696123e-01f, 5.555702330e-01f}, {-8.577286100e-01f, 5.141027442e-01f}, {-8.819212643e-01f, 4.713967368e-01f}, {-9.039892931e-01f, 4.275550934e-01f}, {-9.238795325e-01f, 3.826834324e-01f}, {-9.415440652e-01f, 3.368898534e-01f}, {-9.569403357e-01f, 2.902846773e-01f}, {-9.700312532e-01f, 2.429801799e-01f}, {-9.807852804e-01f, 1.950903220e-01f}, {-9.891765100e-01f, 1.467304745e-01f}, {-9.951847267e-01f, 9.801714033e-02f}, {-9.987954562e-01f, 4.906767433e-02f}, {-1.000000000e+00f, 1.224646799e-16f}, {-9.987954562e-01f, -4.906767433e-02f}, {-9.951847267e-01f, -9.801714033e-02f}, {-9.891765100e-01f, -1.467304745e-01f}, {-9.807852804e-01f, -1.950903220e-01f}, {-9.700312532e-01f, -2.429801799e-01f}, {-9.569403357e-01f, -2.902846773e-01f}, {-9.415440652e-01f, -3.368898534e-01f}, {-9.238795325e-01f, -3.826834324e-01f}, {-9.039892931e-01f, -4.275550934e-01f}, {-8.819212643e-01f, -4.713967368e-01f}, {-8.577286100e-01f, -5.141027442e-01f}, {-8.314696123e-01f, -5.555702330e-01f}, {-8.032075315e-01f, -5.956993045e-01f}, {-7.730104534e-01f, -6.343932842e-01f}, {-7.409511254e-01f, -6.715589548e-01f}, {-7.071067812e-01f, -7.071067812e-01f}, {-6.715589548e-01f, -7.409511254e-01f}, {-6.343932842e-01f, -7.730104534e-01f}, {-5.956993045e-01f, -8.032075315e-01f}, {-5.555702330e-01f, -8.314696123e-01f}, {-5.141027442e-01f, -8.577286100e-01f}, {-4.713967368e-01f, -8.819212643e-01f}, {-4.275550934e-01f, -9.039892931e-01f}, {-3.826834324e-01f, -9.238795325e-01f}, {-3.368898534e-01f, -9.415440652e-01f}, {-2.902846773e-01f, -9.569403357e-01f}, {-2.429801799e-01f, -9.700312532e-01f}, {-1.950903220e-01f, -9.807852804e-01f}, {-1.467304745e-01f, -9.891765100e-01f}, {-9.801714033e-02f, -9.951847267e-01f}, {-4.906767433e-02f, -9.987954562e-01f}, {-1.836970199e-16f, -1.000000000e+00f}, {4.906767433e-02f, -9.987954562e-01f}, {9.801714033e-02f, -9.951847267e-01f}, {1.467304745e-01f, -9.891765100e-01f}, {1.950903220e-01f, -9.807852804e-01f}, {2.429801799e-01f, -9.700312532e-01f}, {2.902846773e-01f, -9.569403357e-01f}, {3.368898534e-01f, -9.415440652e-01f}, {3.826834324e-01f, -9.238795325e-01f}, {4.275550934e-01f, -9.039892931e-01f}, {4.713967368e-01f, -8.819212643e-01f}, {5.141027442e-01f, -8.577286100e-01f}, {5.555702330e-01f, -8.314696123e-01f}, {5.956993045e-01f, -8.032075315e-01f}, {6.343932842e-01f, -7.730104534e-01f}, {6.715589548e-01f, -7.409511254e-01f}, {7.071067812e-01f, -7.071067812e-01f}, {7.409511254e-01f, -6.715589548e-01f}, {7.730104534e-01f, -6.343932842e-01f}, {8.032075315e-01f, -5.956993045e-01f}, {8.314696123e-01f, -5.555702330e-01f}, {8.577286100e-01f, -5.141027442e-01f}, {8.819212643e-01f, -4.713967368e-01f}, {9.039892931e-01f, -4.275550934e-01f}, {9.238795325e-01f, -3.826834324e-01f}, {9.415440652e-01f, -3.368898534e-01f}, {9.569403357e-01f, -2.902846773e-01f}, {9.700312532e-01f, -2.429801799e-01f}, {9.807852804e-01f, -1.950903220e-01f}, {9.891765100e-01f, -1.467304745e-01f}, {9.951847267e-01f, -9.801714033e-02f}, {9.987954562e-01f, -4.906767433e-02f}};

constexpr int NWAVES = 8;
constexpr int RING_BYTES = 131072;
constexpr int MISC_OFF = 146432;
constexpr int MISC_CS128_OFF = 145408;
constexpr int LDS_BYTES = 147456;

#define XB_TMO      128
#define XB_XCNT(j)  (256  + 64 * (j))
#define XB_XSUB(j)  (1280 + 64 * (j))
#define XB_XGEN(j)  (2304 + 64 * (j))
#define XB_TOP      3328
#define XB_TOPGEN   3392
#define XCD_BAR_WORDS 3456
#define XB_SPIN_CAP (1u << 18)
__device__ __forceinline__ unsigned xb_ld(unsigned* p)              { return __hip_atomic_load(p, __ATOMIC_RELAXED, __HIP_MEMORY_SCOPE_AGENT); }
__device__ __forceinline__ unsigned xb_add(unsigned* p, unsigned v) { return __hip_atomic_fetch_add(p, v, __ATOMIC_RELAXED, __HIP_MEMORY_SCOPE_AGENT); }
__device__ __forceinline__ unsigned xb_xcc_id() { return (unsigned)__builtin_amdgcn_s_getreg((3 << 11) | 20) & 0xFu; }
#define XB_SPIN(cond, bar) do { unsigned _sp = 0; while (cond) { __builtin_amdgcn_s_sleep(1); \
    if ((++_sp & 255u) == 0u) { if (xb_ld(&(bar)[XB_TMO])) break; if (_sp > XB_SPIN_CAP) { atomicAdd(&(bar)[XB_TMO], 1u); break; } } } } while (0)
struct XcdBarrier { unsigned* bar; unsigned x; volatile LAS unsigned* st; };
__device__ __forceinline__ XcdBarrier xcd_barrier_post(unsigned* bar, volatile LAS unsigned* st) {
    XcdBarrier b; b.bar = bar; b.x = xb_xcc_id(); b.st = st;
    if (threadIdx.x == 0) (void)xb_add(&bar[XB_XCNT(b.x)], 1u);
    return b;
}
__device__ __forceinline__ void xcd_barrier_complete(unsigned* bar, unsigned x, unsigned& nloc, unsigned& nx) {
    const unsigned G = gridDim.x * gridDim.y * gridDim.z;
    unsigned sum, cnt, mine, sp = 0u;
    for (;;) {
        sum = 0u; cnt = 0u; mine = 0u;
#pragma unroll
        for (unsigned j = 0; j < 16; ++j) { const unsigned c = xb_ld(&bar[XB_XCNT(j)]); sum += c; cnt += (c > 0u) ? 1u : 0u; mine = (j == x) ? c : mine; }
        if (sum == G) break;
        __builtin_amdgcn_s_sleep(1);
        if ((++sp & 255u) == 0u) { if (xb_ld(&bar[XB_TMO])) break; if (sp > XB_SPIN_CAP) { atomicAdd(&bar[XB_TMO], 1u); break; } }
    }
    nloc = mine > 0u ? mine : 1u; nx = cnt > 0u ? cnt : 1u;
}
__device__ __forceinline__ void xcd_barrier(const XcdBarrier& b) {
    asm volatile("s_waitcnt vmcnt(0)" ::: "memory");
    __syncthreads();
    if (threadIdx.x == 0) {
        unsigned* bar = b.bar;
        __builtin_amdgcn_s_waitcnt(0);
        unsigned nloc = b.st[0], nx = b.st[1];
        if (nloc == 0u) { xcd_barrier_complete(bar, b.x, nloc, nx); b.st[0] = nloc; b.st[1] = nx; }
        const unsigned old = xb_add(&bar[XB_XSUB(b.x)], 1u);
        const unsigned gen = old / nloc;
        if (old + 1u == (gen + 1u) * nloc) {
            __builtin_amdgcn_fence(__ATOMIC_RELEASE, "agent");
            asm volatile("s_waitcnt vmcnt(0)" ::: "memory");
            const unsigned og = xb_add(&bar[XB_TOP], 1u);
            const unsigned tg = og / nx;
            if (og + 1u == (tg + 1u) * nx) xb_add(&bar[XB_TOPGEN], 1u);
            else XB_SPIN(xb_ld(&bar[XB_TOPGEN]) == tg, bar);
            __builtin_amdgcn_fence(__ATOMIC_ACQUIRE, "agent");
            xb_add(&bar[XB_XGEN(b.x)], 1u);
            asm volatile("s_waitcnt vmcnt(0)" ::: "memory");
        } else {
            XB_SPIN(xb_ld(&bar[XB_XGEN(b.x)]) == gen, bar);
            __builtin_amdgcn_fence(__ATOMIC_ACQUIRE, "agent");
            asm volatile("s_waitcnt vmcnt(0)" ::: "memory");
        }
    }
    __syncthreads();
}

namespace pg8 {
constexpr int BM = 256, BK = 64, HALF = 128, HTB = HALF * BK * 2, STAGE_BYTES = 8 * HTB;
__device__ __forceinline__ int lds_byte(int r, int c) { const int st = (r >> 4) * 2 + (c >> 5), rr = r & 15, cc = c & 31, ob = rr * 64 + cc * 2; return st * 1024 + (ob ^ (((ob >> 9) & 1) << 5)); }
__device__ __forceinline__ void stage_rc(int b, int& R, int& C) { const int st = b / 1024, sb = b % 1024, swz = sb ^ (((sb >> 9) & 1) << 5); R = (st >> 1) * 16 + swz / 64; C = (st & 1) * 32 + (swz % 64) / 2; }
__device__ __forceinline__ int perm32(int rho) { const int n = rho >> 4, i = rho & 15; return 8 * (i >> 2) + 4 * n + (i & 3); }

struct Unit { const char* a; const char* b; char* o; int ldc; int flags; int pm; int pn; };

enum { PAT_NAT = 0, PAT_PERM = 1, PAT_FFT = 2 };
template <int PAT> __device__ __forceinline__ int brow(int R) {
    if (PAT == PAT_NAT) return R;
    const int Rb = (R & ~31) + perm32(R & 31);
    if (PAT == PAT_PERM) return Rb;
    return (Rb >> 6) + 128 * (Rb & 63);
}
template <int PAT> __device__ __forceinline__ size_t bhstep(int K) { return PAT == PAT_FFT ? (size_t)2 * K * 2 : (size_t)HALF * K * 2; }

template <int PAT0, int PAT1, class Sched, class Epi>
__device__ __forceinline__ void gemm_phase(LAS unsigned char* lds, const int K, const Sched& S, const Epi& E) {
    const int tid = threadIdx.x, wid = __builtin_amdgcn_readfirstlane(tid >> 6), lane = tid & 63, wr = wid >> 2, wc = wid & 3, fr = lane & 15, fq = lane >> 4;
    const int nt = K / BK;
    unsigned voffA[2], voffB0[2], voffB1[2];
#pragma unroll
    for (int i = 0; i < 2; ++i) { int R, C; stage_rc(tid * 16 + i * 8192, R, C);
        voffA[i] = (unsigned)(R * K + C) * 2u; voffB0[i] = (unsigned)(brow<PAT0>(R) * K + C) * 2u; voffB1[i] = (unsigned)(brow<PAT1>(R) * K + C) * 2u; }
    const size_t kstep = (size_t)(BK * 2);
    const size_t hstepA = (size_t)HALF * K * 2;
    const size_t hsB0 = bhstep<PAT0>(K), hsB1 = bhstep<PAT1>(K);
    const unsigned ldsw = (unsigned)wid * 1024u;
    const int aoff = lds_byte(wr * 64 + fr, fq * 8), boff = lds_byte(wc * 32 + fr, fq * 8);
#define PG8_SA(b, h) (((b) * 2 + (h)) * HTB)
#define PG8_SB(b, h) ((4 + (b) * 2 + (h)) * HTB)
#define PG8_STAGE(bufoff, gbase, v0, v1) do { \
        __builtin_amdgcn_global_load_lds((const unsigned*)((const char*)(gbase) + (v0)), (LAS unsigned*)(lds + (bufoff) + ldsw), 16, 0, 0); \
        __builtin_amdgcn_global_load_lds((const unsigned*)((const char*)(gbase) + (v1)), (LAS unsigned*)(lds + (bufoff) + ldsw + 8192), 16, 0, 0); } while (0)
#define PG8_LDA(dst, b, h) do { _Pragma("unroll") for (int m = 0; m < 4; ++m) _Pragma("unroll") for (int k = 0; k < 2; ++k) dst[m][k] = *(const LAS bf16x8*)(lds + PG8_SA(b, h) + aoff + m * 2048 + k * 1024); } while (0)
#define PG8_LDB(dst, b, h) do { _Pragma("unroll") for (int n = 0; n < 2; ++n) _Pragma("unroll") for (int k = 0; k < 2; ++k) dst[n][k] = *(const LAS bf16x8*)(lds + PG8_SB(b, h) + boff + n * 2048 + k * 1024); } while (0)
#define PG8_MMA(ai, bj, At, Bt) do { __builtin_amdgcn_s_setprio(1); _Pragma("unroll") for (int m = 0; m < 4; ++m) _Pragma("unroll") for (int n = 0; n < 2; ++n) _Pragma("unroll") for (int k = 0; k < 2; ++k) \
        acc[ai][bj][m][n] = __builtin_amdgcn_mfma_f32_16x16x32_bf16(Bt[n][k], At[m][k], acc[ai][bj][m][n], 0, 0, 0); __builtin_amdgcn_s_setprio(0); } while (0)
#define PG8_WAIT_V(n) asm volatile("s_waitcnt vmcnt(" #n ")" ::: "memory")
#define PG8_WAIT_L(n) asm volatile("s_waitcnt lgkmcnt(" #n ")" ::: "memory")
#define PG8_BAR __builtin_amdgcn_s_barrier()
#define PG8_SCHED __builtin_amdgcn_sched_barrier(0)
    Unit cur, nxt; int ui = 0;
    if (!S.next(0, cur)) return;
    f32x4 acc[2][2][4][2];
#pragma unroll
    for (int a = 0; a < 2; ++a)
#pragma unroll
        for (int b = 0; b < 2; ++b)
#pragma unroll
            for (int m = 0; m < 4; ++m)
#pragma unroll
                for (int n = 0; n < 2; ++n) acc[a][b][m][n] = (f32x4){0.f, 0.f, 0.f, 0.f};
    bf16x8 At[4][2], B0[2][2], B1[2][2];
    const char* cA = cur.a; const char* cB = cur.b;
    unsigned cv0 = (cur.flags & 1) ? voffB1[0] : voffB0[0], cv1 = (cur.flags & 1) ? voffB1[1] : voffB0[1];
    size_t chb = (cur.flags & 1) ? hsB1 : hsB0;
    PG8_STAGE(PG8_SB(0, 0), cB, cv0, cv1); PG8_STAGE(PG8_SA(0, 0), cA, voffA[0], voffA[1]); PG8_STAGE(PG8_SB(0, 1), cB + chb, cv0, cv1); PG8_STAGE(PG8_SA(0, 1), cA + hstepA, voffA[0], voffA[1]);
    if (wr == 1) PG8_BAR;
    PG8_WAIT_V(4); PG8_BAR;
    PG8_STAGE(PG8_SB(1, 0), cB + kstep, cv0, cv1); PG8_STAGE(PG8_SA(1, 0), cA + kstep, voffA[0], voffA[1]); PG8_STAGE(PG8_SB(1, 1), cB + chb + kstep, cv0, cv1);
    PG8_WAIT_V(6); PG8_BAR;
    for (;;) {
        const bool has_next = S.next(ui + 1, nxt);
        const char* nA = has_next ? nxt.a : cA; const char* nB = has_next ? nxt.b : cB;
        const unsigned nv0 = has_next ? ((nxt.flags & 1) ? voffB1[0] : voffB0[0]) : cv0, nv1 = has_next ? ((nxt.flags & 1) ? voffB1[1] : voffB0[1]) : cv1;
        const size_t nhb = has_next ? ((nxt.flags & 1) ? hsB1 : hsB0) : chb;
        for (int t = 0; t < nt; t += 2) {
            const bool last = (t == nt - 2);
            const char* a1 = cA + (size_t)(t + 1) * kstep;
            const char* a2 = last ? nA : cA + (size_t)(t + 2) * kstep; const char* b2 = last ? nB : cB + (size_t)(t + 2) * kstep;
            const unsigned w0 = last ? nv0 : cv0, w1 = last ? nv1 : cv1; const size_t hb2 = last ? nhb : chb;
            const char* a3 = a2 + kstep; const char* b3 = b2 + kstep;
            PG8_LDB(B0, 0, 0); PG8_SCHED; PG8_LDA(At, 0, 0); PG8_STAGE(PG8_SA(1, 1), a1 + hstepA, voffA[0], voffA[1]);
            PG8_WAIT_L(8); PG8_BAR; PG8_WAIT_L(0); PG8_MMA(0, 0, At, B0); PG8_BAR; PG8_SCHED;
            PG8_LDB(B1, 0, 1); PG8_STAGE(PG8_SB(0, 0), b2, w0, w1);
            PG8_BAR; PG8_WAIT_L(0); PG8_MMA(0, 1, At, B1); PG8_BAR;
            PG8_LDA(At, 0, 1); PG8_STAGE(PG8_SA(0, 0), a2, voffA[0], voffA[1]);
            PG8_BAR; PG8_WAIT_L(0); PG8_MMA(1, 0, At, B0); PG8_BAR; PG8_SCHED;
            PG8_STAGE(PG8_SB(0, 1), b2 + hb2, w0, w1);
            PG8_WAIT_V(6); PG8_BAR; PG8_MMA(1, 1, At, B1); PG8_BAR;
            PG8_LDB(B0, 1, 0); PG8_SCHED; PG8_LDA(At, 1, 0); PG8_STAGE(PG8_SA(0, 1), a2 + hstepA, voffA[0], voffA[1]);
            PG8_WAIT_L(8); PG8_BAR; PG8_WAIT_L(0); PG8_MMA(0, 0, At, B0); PG8_BAR; PG8_SCHED;
            PG8_LDB(B1, 1, 1); PG8_STAGE(PG8_SB(1, 0), b3, w0, w1);
            PG8_BAR; PG8_WAIT_L(0); PG8_MMA(0, 1, At, B1); PG8_BAR;
            PG8_LDA(At, 1, 1); PG8_STAGE(PG8_SA(1, 0), a3, voffA[0], voffA[1]);
            PG8_BAR; PG8_WAIT_L(0); PG8_MMA(1, 0, At, B0); PG8_BAR; PG8_SCHED;
            PG8_STAGE(PG8_SB(1, 1), b3 + hb2, w0, w1);
            PG8_WAIT_V(6); PG8_BAR; PG8_MMA(1, 1, At, B1); PG8_BAR;
        }
        E(acc, cur, wr, wc, fr, fq);
        if (!has_next) break;
#pragma unroll
        for (int a = 0; a < 2; ++a)
#pragma unroll
            for (int b = 0; b < 2; ++b)
#pragma unroll
                for (int m = 0; m < 4; ++m)
#pragma unroll
                    for (int n = 0; n < 2; ++n) acc[a][b][m][n] = (f32x4){0.f, 0.f, 0.f, 0.f};
        cur = nxt; cA = nA; cB = nB; cv0 = nv0; cv1 = nv1; chb = nhb; ++ui;
    }
    PG8_WAIT_V(0);
    if (wr == 0) PG8_BAR;
    PG8_BAR;
#undef PG8_SA
#undef PG8_SB
#undef PG8_STAGE
#undef PG8_LDA
#undef PG8_LDB
#undef PG8_MMA
#undef PG8_WAIT_V
#undef PG8_WAIT_L
#undef PG8_BAR
#undef PG8_SCHED
}

struct EpiBf16 {
    __device__ __forceinline__ void operator()(const f32x4 (&acc)[2][2][4][2], const Unit& u, int wr, int wc, int fr, int fq) const {
        bf16_t* base = (bf16_t*)u.o + (size_t)(wr * 64 + fr) * u.ldc + wc * 32 + 8 * fq;
        const bool act = (u.flags & 16) != 0;
#pragma unroll
        for (int ai = 0; ai < 2; ++ai)
#pragma unroll
            for (int m = 0; m < 4; ++m) { bf16_t* rowp = base + (size_t)(ai * HALF + m * 16) * u.ldc;
#pragma unroll
                for (int bj = 0; bj < 2; ++bj) { f32x4 v0 = acc[ai][bj][m][0], v1 = acc[ai][bj][m][1];
                    if (act) {
#pragma unroll
                        for (int j = 0; j < 4; ++j) { v0[j] = fsilu(v0[j]); v1[j] = fsilu(v1[j]); } }
                    u32x4 w; w.x = pk2(v0[0], v0[1]); w.y = pk2(v0[2], v0[3]); w.z = pk2(v1[0], v1[1]); w.w = pk2(v1[2], v1[3]);
                    *(u32x4*)(rowp + bj * HALF) = w; } }
    }
};
struct EpiOutF32 {
    const float* x; float* out; const float* mod;
    __device__ __forceinline__ void operator()(const f32x4 (&acc)[2][2][4][2], const Unit& u, int wr, int wc, int fr, int fq) const {
        const int row0 = u.pm * BM + wr * 64 + fr, col0 = u.pn * BM + wc * 32 + 4 * fq;
        const int b = (u.pm * BM) / TT;
        f32x4 gv[2][2];
#pragma unroll
        for (int bj = 0; bj < 2; ++bj)
#pragma unroll
            for (int n = 0; n < 2; ++n) gv[bj][n] = *(const f32x4*)(mod + b * 3072 + 2048 + col0 + bj * HALF + n * 16);
#pragma unroll
        for (int ai = 0; ai < 2; ++ai)
#pragma unroll
            for (int m = 0; m < 4; ++m) { const size_t off = (size_t)(row0 + ai * HALF + m * 16) * DM + col0;
#pragma unroll
                for (int bj = 0; bj < 2; ++bj)
#pragma unroll
                    for (int n = 0; n < 2; ++n) { const f32x4 xv = *(const f32x4*)(x + off + bj * HALF + n * 16);
                        *(f32x4*)(out + off + bj * HALF + n * 16) = xv + gv[bj][n] * acc[ai][bj][m][n]; } }
    }
};
}

struct Args { const float* in[18]; float* out; unsigned char* ws; int ph_lo, ph_hi; };
struct Frame {
    LAS unsigned char* lds; volatile LAS unsigned* MISC; unsigned* ctl;
    int tid, lane, wave, G, bid, vcu;
    unsigned char* ws;
};
#define WSP(T, off) ((T*)(F.ws + (off)))

__device__ __forceinline__ void transpose_item(const float* W, int ldw, bf16_t* WT, int ldt, LAS float* scr, int kb, int nb, int lane) {
    const int k0 = 64 * kb, n0 = 32 * nb;
#pragma unroll 8
    for (int i = 0; i < 32; ++i) { const int kk = 2 * i + (lane >> 5); scr[kk * 33 + (lane & 31)] = W[(size_t)(k0 + kk) * ldw + n0 + (lane & 31)]; }
    LDS_WAIT(); asm volatile("" ::: "memory");
    const int c = lane & 7;
#pragma unroll
    for (int j = 0; j < 4; ++j) { const int n = (lane >> 3) + 8 * j; const LAS float* s = scr + (8 * c) * 33 + n;
        u32x4 o; o.x = pk2(s[0 * 33], s[1 * 33]); o.y = pk2(s[2 * 33], s[3 * 33]); o.z = pk2(s[4 * 33], s[5 * 33]); o.w = pk2(s[6 * 33], s[7 * 33]);
        *(u32x4*)(WT + (size_t)(n0 + n) * ldt + k0 + 8 * c) = o; }
    LDS_WAIT(); asm volatile("" ::: "memory");
}
struct SchedP1 {
    int G, c; unsigned char* ws;
    __device__ __forceinline__ bool next(int i, pg8::Unit& u) const {
        const int L = i * G + c;
        if (L < 256) {
            const int x = L & 7, j = L >> 3, pm = j & 3, pn = x * 8 + (j >> 2), b = pn >> 5, pnl = pn & 31;
            u.a = (const char*)(ws + WS_WFOLD) + (size_t)pm * 256 * DM * 2;
            u.b = (const char*)(ws + WS_HX) + ((size_t)b * TT + 4 * pnl) * DM * 2;
            u.o = (char*)(ws + WS_ZT) + ((size_t)pm * 256 * MLAT + (size_t)pn * 256) * 2;
            u.ldc = MLAT; u.flags = 1; u.pm = pm; u.pn = pn; return true;
        }
        const int Lr = L - 256; int pm, pn;
        if (Lr < 384) { const int x = Lr & 7, j = Lr >> 3; pm = 8 * x + (j & 7); pn = j >> 3; }
        else if (Lr < 388) { const int q = Lr - 384; pm = 64 + (q >> 1); pn = 2 + (q & 1); }
        else return false;
        const int seg = pn >> 1;
        u.a = (const char*)(ws + WS_HX) + (size_t)pm * 256 * DM * 2;
        u.b = (const char*)(ws + WS_WREST) + (size_t)pn * 256 * DM * 2;
        unsigned char* ob = ws + (seg == 0 ? WS_GF : (seg == 1 ? WS_UL : WS_GL));
        u.o = (char*)ob + ((size_t)pm * 256 * 512 + (size_t)(pn & 1) * 256) * 2;
        u.ldc = 512; u.flags = (seg != 1) ? 16 : 0; u.pm = pm; u.pn = pn; return true;
    }
};
struct SchedP4 {
    int G, c; unsigned char* ws;
    __device__ __forceinline__ bool next(int i, pg8::Unit& u) const {
        const int L = i * G + c; if (L >= 256) return false;
        const int x = L & 7, j = L >> 3, pm = 8 * x + (j & 7), pn = j >> 3;
        u.a = (const char*)(ws + WS_Y) + (size_t)pm * 256 * DM * 2;
        u.b = (const char*)(ws + WS_WOUT) + (size_t)pn * 256 * DM * 2;
        u.o = nullptr; u.ldc = DM; u.flags = 0; u.pm = pm; u.pn = pn; return true;
    }
};

__device__ __forceinline__ float wave_sum(float v) {
#pragma unroll
    for (int o = 1; o < 64; o <<= 1) v += __shfl_xor(v, o);
    return v;
}
struct SchedFold {
    int G, c; unsigned char* ws;
    __device__ __forceinline__ bool next(int i, pg8::Unit& u) const {
        const int L = i * G + c; if (L >= 16) return false;
        const int pm = L >> 2, pn = L & 3;
        u.a = (const char*)(ws + WS_MT) + (size_t)pm * 256 * 512 * 2;
        u.b = (const char*)(ws + WS_WINF) + (size_t)pn * 256 * 512 * 2;
        u.o = (char*)(ws + WS_WFOLD) + ((size_t)pm * 256 * DM + (size_t)pn * 256) * 2;
        u.ldc = DM; u.flags = 0; u.pm = pm; u.pn = pn; return true;
    }
};

__device__ __forceinline__ void p0_prep(Frame& F, const Args& args) {
    LAS float* scr = (LAS float*)(F.lds + F.wave * 16384);
    const int gw = F.wave * F.G + F.bid, NGW = F.G * NWAVES, lane = F.lane;
    const float* w_in = args.in[7]; const float* w_out = args.in[16]; const float* w_rg = args.in[11]; const float* w_ig = args.in[13];
    const float* w4 = args.in[8]; const float* w_ada = args.in[4];
    constexpr int I_MT = 512, I_MOD = 384, I_REST = 16 * 48, I_OUT = 16 * 32, I_G = 16 * 8, I_WINF = 1024;
    for (int it = gw; it < I_MT + I_MOD + I_REST + I_OUT + I_G + I_WINF; it += NGW) {
        int r = it;
        if (r < I_MT) {
            const int g = r >> 7, ob = (r >> 4) & 7, cb = r & 15, o = 64 * ob + lane, c0 = 8 * cb;
            float aC[8], aS[8];
#pragma unroll
            for (int cc = 0; cc < 8; ++cc) { aC[cc] = 0.f; aS[cc] = 0.f; }
            const float* wp = w4 + (size_t)(g * 128) * 512 + o;
#pragma unroll 4
            for (int m = 0; m < 128; ++m) {
                const float wv = wp[(size_t)m * 512];
#pragma unroll
                for (int cc = 0; cc < 8; ++cc) { const float2 t = CS128C[(m * (c0 + cc)) & 127]; aC[cc] += wv * t.x; aS[cc] += wv * t.y; }
            }
            const float sc = 1.0f / 1024.0f;
            u32x4 oc, os;
            oc.x = pk2(aC[0] * sc, aC[1] * sc); oc.y = pk2(aC[2] * sc, aC[3] * sc); oc.z = pk2(aC[4] * sc, aC[5] * sc); oc.w = pk2(aC[6] * sc, aC[7] * sc);
            os.x = pk2(-aS[0] * sc, -aS[1] * sc); os.y = pk2(-aS[2] * sc, -aS[3] * sc); os.z = pk2(-aS[4] * sc, -aS[5] * sc); os.w = pk2(-aS[6] * sc, -aS[7] * sc);
            bf16_t* mt = WSP(bf16_t, WS_MT);
            *(u32x4*)(mt + (size_t)o * 512 + g * 128 + c0) = oc;
            *(u32x4*)(mt + (size_t)(512 + o) * 512 + g * 128 + c0) = os;
            continue;
        } r -= I_MT;
        if (r < I_MOD) {
            const int nb = r >> 3, kb = r & 7, n = 64 * nb + lane;
            float sv[3][2];
#pragma unroll
            for (int rr = 0; rr < 3; ++rr) { const float* cv = rr < 2 ? args.in[1] + rr * DM : args.in[3];
#pragma unroll
                for (int q = 0; q < 2; ++q) { const float v = cv[128 * kb + 64 * q + lane]; sv[rr][q] = v / (1.0f + __expf(-v)); } }
            float acc[3] = {0.f, 0.f, 0.f};
            const float* wp = w_ada + (size_t)(128 * kb) * 3072 + n;
#pragma unroll
            for (int kk = 0; kk < 128; ++kk) {
                const float wv = wp[(size_t)kk * 3072];
#pragma unroll
                for (int rr = 0; rr < 3; ++rr) acc[rr] += wv * __uint_as_float(__builtin_amdgcn_readlane(__float_as_uint(sv[rr][kk >> 6]), kk & 63));
            }
            float* mp = WSP(float, WS_MODP) + (size_t)kb * 3 * 3072 + n;
#pragma unroll
            for (int rr = 0; rr < 3; ++rr) mp[rr * 3072] = acc[rr];
            continue;
        } r -= I_MOD;
        if (r < I_REST) { transpose_item(w_in + 512, 2048, WSP(bf16_t, WS_WREST), DM, scr, r / 48, r % 48, lane); continue; } r -= I_REST;
        if (r < I_OUT) { transpose_item(w_out, DM, WSP(bf16_t, WS_WOUT), DM, scr, r / 32, r % 32, lane); continue; } r -= I_OUT;
        if (r < I_G) { const int mi = r >> 3, q = r & 7, dir = mi >> 3, gate = (mi >> 2) & 1, h = mi & 3;
          const float* src = (gate ? w_ig : w_rg) + ((size_t)dir * 4 + h) * 16384;
          transpose_item(src, 128, WSP(bf16_t, WS_WG) + (size_t)mi * 16384, 128, scr, q >> 2, q & 3, lane); continue; } r -= I_G;
        {
            const f32x4* src = (const f32x4*)(w_in + (size_t)r * 2048) + 2 * lane; const f32x4 v0 = src[0], v1 = src[1];
            u32x4 o; o.x = pk2(v0[0], v0[1]); o.y = pk2(v0[2], v0[3]); o.z = pk2(v1[0], v1[1]); o.w = pk2(v1[2], v1[3]);
            *(u32x4*)(WSP(bf16_t, WS_WINF) + (size_t)r * 512 + 8 * lane) = o;
        }
    }
}

constexpr int CW_HXROW = 64;
__device__ __forceinline__ void p0b_fold_hx(Frame& F, const Args& args) {
    if (F.bid < 16) { SchedFold S{F.G, F.bid, F.ws}; pg8::EpiBf16 E; pg8::gemm_phase<pg8::PAT_PERM, pg8::PAT_PERM>(F.lds, 512, S, E); }
    __syncthreads();
    LAS float* Sv = (LAS float*)F.lds; LAS float* Sh = Sv + 3072;
    const float* modp = WSP(const float, WS_MODP); const float* b_ada = args.in[5]; const float* g = args.in[6];
    for (int i = F.tid; i < 3 * 3072; i += NWAVES * 64) {
        const int rr = i / 3072, n = i % 3072; float v = b_ada[n];
#pragma unroll
        for (int kb = 0; kb < 8; ++kb) v += modp[(size_t)kb * 9216 + i];
        if (n < 1024) Sh[rr * 1024 + n] = v; else if (n < 2048) Sv[rr * 1024 + (n - 1024)] = g[n - 1024] * (1.0f + v);
        if (F.bid == 0) WSP(float, WS_MOD)[i] = v;
    }
    __syncthreads();
    const float* x = args.in[0]; const float* ctx = args.in[2]; bf16_t* hx = WSP(bf16_t, WS_HX);
    {
        const int nfold = F.G > 32 ? 16 : 0;
        if (F.bid >= nfold) {
            const int gw = (F.bid - nfold) + F.wave * (F.G - nfold), NGW = (F.G - nfold) * NWAVES;
            for (int row = gw; row < MTOT; row += NGW) {
                const float* xr; int mr;
                if (row < MLAT) { xr = x + (size_t)row * DM; mr = row / TT; } else { xr = ctx + (size_t)(row - MLAT) * DM; mr = 2; }
                const f32x4* xp = (const f32x4*)xr + F.lane; f32x4 v[4]; float s = 0.f;
#pragma unroll
                for (int j = 0; j < 4; ++j) { v[j] = xp[64 * j]; s += (v[j][0] * v[j][0] + v[j][1] * v[j][1]) + (v[j][2] * v[j][2] + v[j][3] * v[j][3]); }
                const float rstd = rsqrtf(wave_sum(s) * (1.0f / DM) + 1e-6f);
                u32x2* o8 = (u32x2*)(hx + (size_t)row * DM) + F.lane;
#pragma unroll
                for (int j = 0; j < 4; ++j) { const f32x4 sc = *(const LAS f32x4*)(Sv + mr * 1024 + 256 * j + 4 * F.lane), sh = *(const LAS f32x4*)(Sh + mr * 1024 + 256 * j + 4 * F.lane);
                    const f32x4 h = v[j] * rstd * sc + sh; u32x2 w; w.x = pk2(h[0], h[1]); w.y = pk2(h[2], h[3]); o8[64 * j] = w; }
            }
        }
    }
}

__device__ __forceinline__ void p5_final(Frame& F, const Args& args) {
    const int gw = F.vcu * NWAVES + F.wave, NGW = F.G * NWAVES; const float* fg = args.in[17];
    f32x4 gv[4];
#pragma unroll
    for (int j = 0; j < 4; ++j) gv[j] = ((const f32x4*)fg)[64 * j + F.lane];
    for (int row = gw; row < MLAT; row += NGW) {
        f32x4* xp = (f32x4*)(args.out + (size_t)row * DM) + F.lane; f32x4 v[4]; float s = 0.f;
#pragma unroll
        for (int j = 0; j < 4; ++j) { v[j] = xp[64 * j]; s += (v[j][0] * v[j][0] + v[j][1] * v[j][1]) + (v[j][2] * v[j][2] + v[j][3] * v[j][3]); }
        const float rstd = rsqrtf(wave_sum(s) * (1.0f / DM) + 1e-6f);
#pragma unroll
        for (int j = 0; j < 4; ++j) xp[64 * j] = v[j] * rstd * gv[j];
    }
}

constexpr int FFT_F1_OFF = 0, FFT_TW_OFF = 65536;
__device__ __forceinline__ int crow(int reg, int h) { return (reg & 3) + 8 * (reg >> 2) + 4 * h; }
#define MFMA32(a, b, c) __builtin_amdgcn_mfma_f32_32x32x16_bf16((a), (b), (c), 0, 0, 0)
__device__ __forceinline__ bf16x8 neg8(bf16x8 v) { u32x4 u = __builtin_bit_cast(u32x4, v); u ^= 0x80008000u; return __builtin_bit_cast(bf16x8, u); }

__device__ __forceinline__ void fft_tables(Frame& F) {
    LAS f32x2* cs128 = (LAS f32x2*)(F.lds + MISC_CS128_OFF);
    for (int e = F.tid; e < 64 * 64; e += NWAVES * 64) {
        const int f = e >> 6, lane = e & 63, r = lane & 31, hh = lane >> 5, plane = f & 1, s = (f >> 1) & 1, j = (f >> 2) & 3, mt = f >> 4;
        const int k1 = 32 * mt + r; float v[8];
#pragma unroll
        for (int jj = 0; jj < 8; ++jj) { const int n1 = 32 * j + 16 * s + 8 * (jj >> 2) + 4 * hh + (jj & 3); const f32x2 t = cs128[(k1 * n1) & 127]; v[jj] = plane ? t.y : t.x; }
        u32x4 o; o.x = pk2(v[0], v[1]); o.y = pk2(v[2], v[3]); o.z = pk2(v[4], v[5]); o.w = pk2(v[6], v[7]);
        *(LAS u32x4*)(F.lds + FFT_F1_OFF + e * 16) = o;
    }
    for (int e = F.tid; e < 64 * 64; e += NWAVES * 64) {
        const int lane = e & 63, q = (e >> 6) & 7, h = (e >> 9) & 1, j = e >> 10, r = lane & 31, hh = lane >> 5, k2 = 32 * h + r;
        f32x4 o;
        { const int n1 = 32 * j + crow(2 * q, hh); float sv, cv; sincospif((float)(n1 * k2) * (1.0f / 4096.0f), &sv, &cv); o[0] = cv; o[1] = sv; }
        { const int n1 = 32 * j + crow(2 * q + 1, hh); float sv, cv; sincospif((float)(n1 * k2) * (1.0f / 4096.0f), &sv, &cv); o[2] = cv; o[3] = sv; }
        *(LAS f32x4*)(F.lds + FFT_TW_OFF + e * 16) = o;
    }
}

__device__ __forceinline__ void fft_task(Frame& F, int bt) {
    LAS f32x2* cs128 = (LAS f32x2*)(F.lds + MISC_CS128_OFF);
    const int lane = F.lane, r = lane & 31, hh = lane >> 5, w = F.wave, h = w & 1;
    const int col = bt * 4 + (w >> 1), b = col >> 9, chan = col & 511;
    const bf16_t* zr = WSP(const bf16_t, WS_ZT) + (size_t)chan * MLAT + (size_t)b * TT;
    const bf16_t* zi = zr + (size_t)512 * MLAT;
    bf16x8 c2[4], s2[4];
#pragma unroll
    for (int s = 0; s < 4; ++s) { float cv[8], sv[8];
#pragma unroll
        for (int jj = 0; jj < 8; ++jj) { const int n2 = 16 * s + 8 * hh + jj, k2 = 32 * h + r; const f32x2 t = cs128[(2 * n2 * k2) & 127]; cv[jj] = t.x; sv[jj] = t.y; }
        u32x4 oc, os; oc.x = pk2(cv[0], cv[1]); oc.y = pk2(cv[2], cv[3]); oc.z = pk2(cv[4], cv[5]); oc.w = pk2(cv[6], cv[7]);
        os.x = pk2(sv[0], sv[1]); os.y = pk2(sv[2], sv[3]); os.z = pk2(sv[4], sv[5]); os.w = pk2(sv[6], sv[7]);
        c2[s] = __builtin_bit_cast(bf16x8, oc); s2[s] = __builtin_bit_cast(bf16x8, os); }
    f32x16 X[4];
#pragma unroll
    for (int mt = 0; mt < 4; ++mt)
#pragma unroll
        for (int i = 0; i < 16; ++i) X[mt][i] = 0.f;
#pragma unroll 1
    for (int j = 0; j < 4; ++j) {
        f32x16 Tr, Ti;
#pragma unroll
        for (int i = 0; i < 16; ++i) { Tr[i] = 0.f; Ti[i] = 0.f; }
        const size_t rowoff = (size_t)(32 * j + r) * 64 + 8 * hh;
#pragma unroll
        for (int s = 0; s < 4; ++s) {
            const bf16x8 ar = *(const bf16x8*)(zr + rowoff + 16 * s), ai = *(const bf16x8*)(zi + rowoff + 16 * s);
            const bf16x8 arn = neg8(ar);
            Tr = MFMA32(ar, c2[s], Tr); Tr = MFMA32(ai, s2[s], Tr);
            Ti = MFMA32(ai, c2[s], Ti); Ti = MFMA32(arn, s2[s], Ti);
        }
        u32x4 pr[2], pi[2];
#pragma unroll
        for (int q = 0; q < 8; ++q) {
            const f32x4 tw = *(const LAS f32x4*)(F.lds + FFT_TW_OFF + ((((j * 2 + h) * 8 + q) * 64 + lane) * 16));
            const float tr0 = Tr[2 * q], ti0 = Ti[2 * q], tr1 = Tr[2 * q + 1], ti1 = Ti[2 * q + 1];
            const float r0 = tr0 * tw[0] + ti0 * tw[1], i0 = ti0 * tw[0] - tr0 * tw[1];
            const float r1 = tr1 * tw[2] + ti1 * tw[3], i1 = ti1 * tw[2] - tr1 * tw[3];
            pr[q >> 2][q & 3] = pk2(r0, r1); pi[q >> 2][q & 3] = pk2(i0, i1);
        }
#pragma unroll
        for (int mt = 0; mt < 4; ++mt)
#pragma unroll
            for (int s = 0; s < 2; ++s) {
                const bf16x8 fc = *(const LAS bf16x8*)(F.lds + FFT_F1_OFF + ((((mt * 4 + j) * 2 + s) * 2 + 0) * 64 + lane) * 16);
                const bf16x8 fs = *(const LAS bf16x8*)(F.lds + FFT_F1_OFF + ((((mt * 4 + j) * 2 + s) * 2 + 1) * 64 + lane) * 16);
                X[mt] = MFMA32(fc, __builtin_bit_cast(bf16x8, pr[s]), X[mt]);
                X[mt] = MFMA32(fs, __builtin_bit_cast(bf16x8, pi[s]), X[mt]);
            }
    }
    bf16_t* yo = WSP(bf16_t, WS_YFT) + ((size_t)b * 512 + chan) * TT + 32 * h + r;
#pragma unroll
    for (int mt = 0; mt < 4; ++mt)
#pragma unroll
        for (int i = 0; i < 16; ++i) { const int k1 = 32 * mt + crow(i, hh); yo[64 * k1] = f2bf(X[mt][i]); }
}
#define MFMA16(a, b, c) __builtin_amdgcn_mfma_f32_16x16x32_bf16((a), (b), (c), 0, 0, 0)
constexpr int LRU_V_OFF = 0, LRU_V_PITCH = 272;
constexpr int LRU_HB_OFF = 36864, LRU_HB_PITCH = 528;
constexpr int NCI = 66;
constexpr size_t WS_AB = 179 * MiB;
constexpr size_t WS_GS = 244 * MiB;
__device__ __forceinline__ size_t sum_idx(int b, int ci, int dir, int ch) { return ((((size_t)b * NCI + ci) * 2 + dir) * 512 + ch); }
__device__ __forceinline__ float bflo(unsigned u) { return __uint_as_float(u << 16); }
__device__ __forceinline__ float bfhi(unsigned u) { return __uint_as_float(u & 0xffff0000u); }

__device__ __forceinline__ void lru_conv_to_lds(Frame& F, const Args& args, int b, int ci, int hd) {
    const bf16_t* ul = WSP(const bf16_t, WS_UL); const float* conv_w = args.in[9]; const float* conv_b = args.in[10];
    const int c8 = F.tid & 15, tg = F.tid >> 4, ch0 = hd * 128 + 8 * c8;
    int L, t0; size_t rbase;
    if (ci < 2) { L = CTXL; t0 = 128 * ci; rbase = (size_t)MLAT + (size_t)b * CTXL; } else { L = TT; t0 = 128 * (ci - 2); rbase = (size_t)b * TT; }
    float in[7][8];
#pragma unroll
    for (int q = 0; q < 7; ++q) { const int t = t0 + 4 * tg - 2 + q;
        if (t >= 0 && t < L) { const u32x4 v = *(const u32x4*)(ul + (rbase + t) * 512 + ch0);
#pragma unroll
            for (int i = 0; i < 4; ++i) { in[q][2 * i] = bflo(v[i]); in[q][2 * i + 1] = bfhi(v[i]); } }
        else {
#pragma unroll
            for (int i = 0; i < 8; ++i) in[q][i] = 0.f; } }
    float cw[4][8], cb[8];
#pragma unroll
    for (int j = 0; j < 4; ++j) { const f32x4 a = *(const f32x4*)(conv_w + j * 512 + ch0), c = *(const f32x4*)(conv_w + j * 512 + ch0 + 4);
#pragma unroll
        for (int i = 0; i < 4; ++i) { cw[j][i] = a[i]; cw[j][4 + i] = c[i]; } }
    { const f32x4 a = *(const f32x4*)(conv_b + ch0), c = *(const f32x4*)(conv_b + ch0 + 4);
#pragma unroll
      for (int i = 0; i < 4; ++i) { cb[i] = a[i]; cb[4 + i] = c[i]; } }
#pragma unroll
    for (int q = 0; q < 4; ++q) { float v[8];
#pragma unroll
        for (int i = 0; i < 8; ++i) v[i] = cb[i] + cw[0][i] * in[q][i] + cw[1][i] * in[q + 1][i] + cw[2][i] * in[q + 2][i] + cw[3][i] * in[q + 3][i];
        u32x4 o; o.x = pk2(v[0], v[1]); o.y = pk2(v[2], v[3]); o.z = pk2(v[4], v[5]); o.w = pk2(v[6], v[7]);
        *(LAS u32x4*)(F.lds + LRU_V_OFF + (4 * tg + q) * LRU_V_PITCH + c8 * 16) = o; }
}

__device__ __forceinline__ void lru_task1(Frame& F, const Args& args, int task) {
    const int hd = task & 3, rest = task >> 2, b = rest / NCI, ci = rest % NCI;
    const int lane = F.lane, g = lane >> 4, e = lane & 15, w = F.wave, ch = hd * 128 + 16 * w + e;
    const bool latent = ci >= 2;
    bf16x8 Bw[2][2][4];
#pragma unroll
    for (int dir = 0; dir < 2; ++dir)
#pragma unroll
        for (int gate = 0; gate < 2; ++gate) { const bf16_t* wg = WSP(const bf16_t, WS_WG) + ((size_t)(dir * 2 + gate) * 4 + hd) * 16384 + (size_t)(16 * w + e) * 128 + 8 * g;
#pragma unroll
            for (int ks = 0; ks < 4; ++ks) Bw[dir][gate][ks] = *(const bf16x8*)(wg + 32 * ks); }
    const float* b_rg = args.in[12]; const float* b_ig = args.in[14]; const float* lam = args.in[15];
    float brg[2], big[2], c8v[2];
#pragma unroll
    for (int dir = 0; dir < 2; ++dir) { brg[dir] = b_rg[dir * 512 + ch]; big[dir] = b_ig[dir * 512 + ch]; const float lv = lam[dir * 512 + ch]; c8v[dir] = 8.0f * (fmaxf(-lv, 0.f) + log1pf(__expf(-fabsf(lv)))); }
    __syncthreads();
    lru_conv_to_lds(F, args, b, ci, hd);
    __syncthreads();
    float Ac[2] = {1.f, 1.f}, Bc[2] = {0.f, 0.f};
    u32x4* abp = WSP(u32x4, WS_AB) + ((((size_t)((b * 64 + (ci - 2)) * 4 + hd) * 2) * 8) * 8 + w) * 64 + lane;
    const int arow = 32 * (e >> 2) + (e & 3);
#pragma unroll 2
    for (int s = 0; s < 8; ++s) {
        f32x4 acc[2][2];
#pragma unroll
        for (int dir = 0; dir < 2; ++dir)
#pragma unroll
            for (int gate = 0; gate < 2; ++gate) acc[dir][gate] = (f32x4){0.f, 0.f, 0.f, 0.f};
#pragma unroll
        for (int ks = 0; ks < 4; ++ks) {
            const bf16x8 av = *(const LAS bf16x8*)(F.lds + LRU_V_OFF + (arow + 4 * s) * LRU_V_PITCH + (32 * ks + 8 * g) * 2);
#pragma unroll
            for (int dir = 0; dir < 2; ++dir)
#pragma unroll
                for (int gate = 0; gate < 2; ++gate) acc[dir][gate] = MFMA16(av, Bw[dir][gate][ks], acc[dir][gate]);
        }
        unsigned pk[2][4];
#pragma unroll
        for (int i = 0; i < 4; ++i) {
            const float vv = bf2f(*(const LAS bf16_t*)(F.lds + LRU_V_OFF + (32 * g + 4 * s + i) * LRU_V_PITCH + (16 * w + e) * 2));
#pragma unroll
            for (int dir = 0; dir < 2; ++dir) {
                const float rr = fsigm(acc[dir][0][i] + brg[dir]), ii = fsigm(acc[dir][1][i] + big[dir]);
                const float la = -c8v[dir] * rr, x2 = 2.0f * la, a0 = __expf(la);
                const float omp = -x2 * (1.0f + x2 * (0.5f + x2 * (0.16666667f + x2 * 0.041666668f))), omd = 1.0f - a0 * a0;
                const float om = (x2 > -0.02f) ? omp : omd;
                const float bx0 = __builtin_amdgcn_sqrtf(om) * (ii * vv);
                const unsigned p = pk2(la, bx0); pk[dir][i] = p;
                const float a = __expf(bflo(p)), bx = bfhi(p);
                if (dir == 0) { Bc[0] = a * Bc[0] + bx; Ac[0] *= a; } else { Bc[1] += Ac[1] * bx; Ac[1] *= a; }
            }
        }
        if (latent) {
            abp[(size_t)(0 * 8 + s) * 512] = (u32x4){pk[0][0], pk[0][1], pk[0][2], pk[0][3]};
            abp[(size_t)(1 * 8 + s) * 512] = (u32x4){pk[1][0], pk[1][1], pk[1][2], pk[1][3]};
        }
    }
    if (latent) { float2* gs = WSP(float2, WS_GS) + ((size_t)((b * 64 + (ci - 2)) * 4 + hd) * 2 * 8 + w) * 64 + lane;
        gs[0] = make_float2(Ac[0], Bc[0]); gs[(size_t)8 * 64] = make_float2(Ac[1], Bc[1]); }
#pragma unroll
    for (int dir = 0; dir < 2; ++dir) {
        float Ag[4], Bg[4];
#pragma unroll
        for (int gg = 0; gg < 4; ++gg) { Ag[gg] = __shfl(Ac[dir], 16 * gg + e); Bg[gg] = __shfl(Bc[dir], 16 * gg + e); }
        float h = 0.f;
        if (dir == 0) { h = Bg[0]; h = Ag[1] * h + Bg[1]; h = Ag[2] * h + Bg[2]; h = Ag[3] * h + Bg[3]; }
        else          { h = Bg[3]; h = Ag[2] * h + Bg[2]; h = Ag[1] * h + Bg[1]; h = Ag[0] * h + Bg[0]; }
        if (g == 0) WSP(float2, WS_SUM)[sum_idx(b, ci, dir, ch)] = make_float2((Ag[0] * Ag[1]) * (Ag[2] * Ag[3]), h);
    }
}

constexpr int FT_OFF = 104448, FT_PITCH = 260;
__device__ __forceinline__ void lru_task2(Frame& F, const Args& args, int task) {
    const int hd = task & 3, rest = task >> 2, b = rest >> 6, c = rest & 63, ci = c + 2;
    const int lane = F.lane, g = lane >> 4, e = lane & 15, w = F.wave, ch = hd * 128 + 16 * w + e;
    const size_t trow0 = (size_t)b * TT + 128 * c;
    const u32x4* abp = WSP(const u32x4, WS_AB) + ((((size_t)task * 2) * 8) * 8 + w) * 64 + lane;
    u32x4 ab[2][8];
#pragma unroll
    for (int dir = 0; dir < 2; ++dir)
#pragma unroll
        for (int s = 0; s < 8; ++s) ab[dir][s] = abp[(size_t)(dir * 8 + s) * 512];
    float2 gs[2][4];
    { const float2* gp = WSP(const float2, WS_GS) + ((size_t)task * 2 * 8 + w) * 64 + e;
#pragma unroll
      for (int dir = 0; dir < 2; ++dir)
#pragma unroll
          for (int gg = 0; gg < 4; ++gg) gs[dir][gg] = gp[(size_t)dir * 8 * 64 + 16 * gg]; }
    u32x4 yv[4];
    { const int chan = F.tid >> 2, seg = F.tid & 3;
      const bf16_t* src = WSP(const bf16_t, WS_YFT) + ((size_t)b * 512 + hd * 128 + chan) * TT + 128 * c + 32 * seg;
#pragma unroll
      for (int q = 0; q < 4; ++q) yv[q] = *(const u32x4*)(src + 8 * q); }
    float carry[2];
    { const float2* sum = WSP(const float2, WS_SUM);
#pragma unroll
      for (int dir = 0; dir < 2; ++dir) {
          const int n = dir == 0 ? ci : (NCI + 1 - ci);
          float2 v[17];
#pragma unroll
          for (int k = 0; k < 17; ++k) { const int idx = 17 * g + k; const int cj = dir == 0 ? idx : (idx == 0 ? 1 : (idx == 1 ? 0 : NCI + 1 - idx));
              v[k] = (idx < n) ? sum[sum_idx(b, cj, dir, ch)] : make_float2(1.f, 0.f); }
          float A = 1.f, B = 0.f;
#pragma unroll
          for (int k = 0; k < 17; ++k) { B = v[k].x * B + v[k].y; A *= v[k].x; }
          float h = 0.f;
#pragma unroll
          for (int gg = 0; gg < 4; ++gg) { const float Ag = __shfl(A, 16 * gg + e), Bg = __shfl(B, 16 * gg + e); h = Ag * h + Bg; }
          carry[dir] = h; } }
    __syncthreads();
    { const int chan = F.tid >> 2, seg = F.tid & 3;
#pragma unroll
      for (int q = 0; q < 4; ++q) { LAS unsigned* dst = (LAS unsigned*)(F.lds + FT_OFF + chan * FT_PITCH + (32 * seg + 8 * q) * 2);
          dst[0] = yv[q].x; dst[1] = yv[q].y; dst[2] = yv[q].z; dst[3] = yv[q].w; } }
    float hf[8][4];
    { float h = carry[0];
#pragma unroll
      for (int gg = 0; gg < 3; ++gg) h = (gg < g) ? (gs[0][gg].x * h + gs[0][gg].y) : h;
#pragma unroll
      for (int s = 0; s < 8; ++s)
#pragma unroll
          for (int i = 0; i < 4; ++i) { h = __expf(bflo(ab[0][s][i])) * h + bfhi(ab[0][s][i]); hf[s][i] = h; } }
    { float h = carry[1];
#pragma unroll
      for (int gg = 3; gg > 0; --gg) h = (gg > g) ? (gs[1][gg].x * h + gs[1][gg].y) : h;
      const int colsw = ((16 * w + e) ^ (g << 3)) * 4;
#pragma unroll
      for (int s = 7; s >= 0; --s)
#pragma unroll
          for (int i = 3; i >= 0; --i) { h = __expf(bflo(ab[1][s][i])) * h + bfhi(ab[1][s][i]);
              *(LAS float*)(F.lds + LRU_HB_OFF + (32 * g + 4 * s + i) * LRU_HB_PITCH + colsw) = hf[s][i] + h; } }
    __syncthreads();
    bf16_t* y = WSP(bf16_t, WS_Y);
    {
        const int c8 = F.tid & 15, tg = F.tid >> 4; const bf16_t* gl = WSP(const bf16_t, WS_GL);
        u32x4 gv[4];
#pragma unroll
        for (int q = 0; q < 4; ++q) gv[q] = *(const u32x4*)(gl + (trow0 + 4 * tg + q) * 512 + hd * 128 + 8 * c8);
#pragma unroll
        for (int q = 0; q < 4; ++q) { const int tok = 4 * tg + q;
            const LAS f32x4* hp = (const LAS f32x4*)(F.lds + LRU_HB_OFF + tok * LRU_HB_PITCH + ((c8 ^ (tok >> 5)) * 32));
            const f32x4 h0 = hp[0], h1 = hp[1]; u32x4 o;
            o.x = pk2(h0[0] * bflo(gv[q].x), h0[1] * bfhi(gv[q].x)); o.y = pk2(h0[2] * bflo(gv[q].y), h0[3] * bfhi(gv[q].y));
            o.z = pk2(h1[0] * bflo(gv[q].z), h1[1] * bfhi(gv[q].z)); o.w = pk2(h1[2] * bflo(gv[q].w), h1[3] * bfhi(gv[q].w));
            *(u32x4*)(y + (trow0 + tok) * DM + 512 + hd * 128 + 8 * c8) = o; }
    }
    {
        const int tok = F.tid & 127, cq = F.tid >> 7; const bf16_t* gf = WSP(const bf16_t, WS_GF);
        u32x4 gv[4];
#pragma unroll
        for (int c8 = 0; c8 < 4; ++c8) gv[c8] = *(const u32x4*)(gf + (trow0 + tok) * 512 + hd * 128 + 32 * cq + 8 * c8);
#pragma unroll
        for (int c8 = 0; c8 < 4; ++c8) { const int ch0 = 32 * cq + 8 * c8; float v[8];
#pragma unroll
            for (int i = 0; i < 8; ++i) v[i] = bf2f(*(const LAS bf16_t*)(F.lds + FT_OFF + (ch0 + i) * FT_PITCH + tok * 2));
            u32x4 o;
            o.x = pk2(v[0] * bflo(gv[c8].x), v[1] * bfhi(gv[c8].x)); o.y = pk2(v[2] * bflo(gv[c8].y), v[3] * bfhi(gv[c8].y));
            o.z = pk2(v[4] * bflo(gv[c8].z), v[5] * bfhi(gv[c8].z)); o.w = pk2(v[6] * bflo(gv[c8].w), v[7] * bfhi(gv[c8].w));
            *(u32x4*)(y + (trow0 + tok) * DM + hd * 128 + ch0) = o; }
    }
}
__global__ void __launch_bounds__(NWAVES * 64, 2) mk_fwd(Args args) {
    extern __shared__ __attribute__((aligned(16))) unsigned char lds_raw[];
    Frame F;
    F.lds = (LAS unsigned char*)lds_raw;
    F.MISC = (volatile LAS unsigned*)(F.lds + MISC_OFF);
    F.tid = threadIdx.x; F.lane = F.tid & 63; F.wave = __builtin_amdgcn_readfirstlane(F.tid >> 6);
    F.G = gridDim.x; F.bid = blockIdx.x; F.vcu = (F.G % 8 == 0) ? (F.bid % 8) * (F.G / 8) + F.bid / 8 : F.bid;
    F.ws = args.ws; F.ctl = (unsigned*)(args.ws + WS_CTL);
    if (F.tid < 32) F.MISC[F.tid] = 0u;
    if (F.tid >= 64 && F.tid < 192) { const int i = F.tid - 64; float sv, cv; sincospif((float)i * (1.0f / 64.0f), &sv, &cv); ((LAS f32x2*)(F.lds + MISC_CS128_OFF))[i] = (f32x2){cv, sv}; }
    __syncthreads();
    const int lo = args.ph_lo, hi = args.ph_hi;
#ifdef TS_A0
    volatile LAS unsigned long long* TSV = (volatile LAS unsigned long long*)(F.lds + MISC_OFF + 256);
#define TSTAMP(i) do { if (F.tid == 0) TSV[i] = __builtin_amdgcn_s_memrealtime(); } while (0)
#else
#define TSTAMP(i) do { } while (0)
#endif
    TSTAMP(0);
    XcdBarrier bar; bar.bar = F.ctl + 1024; bar.x = 0; bar.st = nullptr;
    if (hi - lo > 1) bar = xcd_barrier_post(F.ctl + 1024, F.MISC + 8);
#ifndef PROBE_REP
#define PROBE_REP -1
#endif
#define REPS(k) ((PROBE_REP == (k)) ? 2 : 1)
#define RB(k) do { if (rep + 1 < REPS(k)) xcd_barrier(bar); } while (0)
#define IN(k) (lo <= (k) && (k) < hi)
#define SEAM(k) do { if (IN(k) && IN((k) + 1)) { xcd_barrier(bar); if (PROBE_REP == 31) xcd_barrier(bar); } } while (0)

    if (IN(0)) for (int rep = 0; rep < REPS(0); ++rep) { p0_prep(F, args); RB(0); }
    TSTAMP(1); SEAM(0); TSTAMP(2);
    if (IN(1)) for (int rep = 0; rep < REPS(1); ++rep) { p0b_fold_hx(F, args); RB(1); }
    TSTAMP(3); SEAM(1); TSTAMP(4);
    if (IN(2)) for (int rep = 0; rep < REPS(2); ++rep) {
        SchedP1 S{F.G, F.bid, F.ws}; pg8::EpiBf16 E;
        pg8::gemm_phase<pg8::PAT_PERM, pg8::PAT_FFT>(F.lds, DM, S, E); RB(2);
    }
    TSTAMP(5); SEAM(2); TSTAMP(6);
    if (IN(3)) for (int rep = 0; rep < REPS(3); ++rep) {
        for (int r4 = 0; r4 < (PROBE_REP == 30 ? 2 : 1); ++r4) { __syncthreads(); fft_tables(F); } __syncthreads(); TSTAMP(7);
        for (int r2 = 0; r2 < (PROBE_REP == 10 ? 2 : 1); ++r2) for (int bt = F.bid; bt < 256; bt += F.G) fft_task(F, bt);
        TSTAMP(8);
        {
            for (;;) {
                __syncthreads();
                if (F.tid == 0) F.MISC[16] = atomicAdd(F.ctl + 64, 1u);
                __syncthreads();
                const int task = (int)F.MISC[16];
                if (task >= 528) break;
                lru_task1(F, args, task);
            }
        }
        RB(3);
    }
    TSTAMP(9); SEAM(3); TSTAMP(10);
    if (IN(4)) for (int rep = 0; rep < REPS(4); ++rep) { for (int task = F.bid; task < 512; task += F.G) lru_task2(F, args, task); RB(4); }
    TSTAMP(11); SEAM(4); TSTAMP(12);
    if (IN(5)) for (int rep = 0; rep < REPS(5); ++rep) {
        SchedP4 S{F.G, F.bid, F.ws}; pg8::EpiOutF32 E{args.in[0], args.out, WSP(const float, WS_MOD)};
        pg8::gemm_phase<pg8::PAT_NAT, pg8::PAT_NAT>(F.lds, DM, S, E); RB(5);
    }
    TSTAMP(13); SEAM(5); TSTAMP(14);
    if (IN(6)) { p5_final(F, args); }
#ifdef TS_A0
    TSTAMP(15);
    xcd_barrier(bar);
    if (F.bid == TS_BLOCK && F.tid == 0) {
        const float ta = (float)(long long)(TSV[TS_A1] - TSV[TS_A0]) * 0.01f, tb = (float)(long long)(TSV[TS_B1] - TSV[TS_B0]) * 0.01f;
        asm volatile("s_waitcnt vmcnt(0)" ::: "memory");
        args.out[(size_t)TS_ROW * DM] += ta;
        for (int k = 1; k <= 10000; ++k) args.out[(size_t)TS_ROW * DM + k * 1024 + 1] += 0.1f * tb;
    }
#endif
#undef IN
#undef SEAM
}

static int g_grid = 0;
static void mk_launch(const Args& base, int lo, int hi, hipStream_t stream) {
    Args a = base; a.ph_lo = lo; a.ph_hi = hi;
    hipLaunchKernelGGL(mk_fwd, dim3(g_grid), dim3(NWAVES * 64), LDS_BYTES, stream, a);
}
extern "C" void kernel_launch(void* const* d_in, const int* in_sizes, int n_in, void* d_out, int out_size, void* d_ws, size_t ws_size, hipStream_t stream) {
    if (g_grid == 0) {
        int dev = 0, cus = 0, per_cu = 0;
        (void)hipGetDevice(&dev); (void)hipDeviceGetAttribute(&cus, hipDeviceAttributeMultiprocessorCount, dev);
        (void)hipFuncSetAttribute((const void*)mk_fwd, hipFuncAttributeMaxDynamicSharedMemorySize, LDS_BYTES);
        (void)hipOccupancyMaxActiveBlocksPerMultiprocessor(&per_cu, (const void*)mk_fwd, NWAVES * 64, LDS_BYTES);
        (void)hipGetLastError();
        g_grid = cus > 0 ? cus : 256;
    }
    (void)hipMemsetAsync((char*)d_ws + WS_CTL, 0, CTL_ZERO_BYTES, stream);
    Args a{}; for (int i = 0; i < 18; ++i) a.in[i] = (const float*)d_in[i]; a.out = (float*)d_out; a.ws = (unsigned char*)d_ws;
    mk_launch(a, 0, 7, stream);
}
```
